# Optimizing an MI355X kernel written in HIP

```python
import jax, jax.numpy as jnp
from jax import lax
import numpy as np

D_MODEL = 2048
BATCH = 4
SEQ = 4096
DEPTH = 1

PLE_DIM = 256
D_MIX = D_MODEL
RWKV_WIDTH = D_MIX // 2
CONV_WIDTH = D_MIX - RWKV_WIDTH
HEAD_SIZE = 64
RWKV_HEADS = RWKV_WIDTH // HEAD_SIZE
DECAY_LORA = 64
ICLR_LORA = 64
GATE_LORA = 160
CONV_K = 3
N_EXPERTS = 32
TOP_K = 4
D_FF = D_MODEL
SWIGLU_LIMIT = 7.0
SWIGLU_ALPHA = 1.702
MOE_BLOCK = 256
RMS_EPS = 1e-5
LNX_EPS = 64e-5
N_RWKV_COLS = 3 * RWKV_WIDTH + 2 * DECAY_LORA + 2 * ICLR_LORA + GATE_LORA
N_IN_COLS = N_RWKV_COLS + 3 * CONV_WIDTH

kernel_name = 'hybrid_rwkv7_shortconv_moe_encoder'


def rms_norm(x, g):
    xf = x.astype(jnp.float32)
    y = xf * lax.rsqrt(jnp.mean(xf * xf, axis=-1, keepdims=True) + RMS_EPS)
    return (y * g.astype(jnp.float32)).astype(x.dtype)


def centred_shift(z):
    zp = jnp.pad(z, ((0, 0), (1, 1), (0, 0)))
    return 0.5 * (zp[:, :-2] + zp[:, 2:])


def wkv7_scan(r, w, k, v, a, b):
    n_dir, bsz, _, n_h, n = r.shape

    def step(S, inp):
        r_t, w_t, k_t, v_t, a_t, b_t = inp
        sa = jnp.einsum('dbhvk,dbhk->dbhv', S, a_t)
        S = (S * w_t[..., None, :] + sa[..., :, None] * b_t[..., None, :]
             + v_t[..., :, None] * k_t[..., None, :])
        return S, jnp.einsum('dbhvk,dbhk->dbhv', S, r_t)

    xs = tuple(jnp.moveaxis(t, 2, 0) for t in (r, w, k, v, a, b))
    S0 = jnp.zeros((n_dir, bsz, n_h, n, n), jnp.float32)
    _, ys = lax.scan(step, S0, xs)
    return jnp.moveaxis(ys, 0, 2)


def rwkv7_mixer(z, w0, w2, a0, a2, g2, k_k, k_a, r_k, lnx_w, lnx_b):
    bsz, T, _ = z.shape
    W, H, N = RWKV_WIDTH, RWKV_HEADS, HEAD_SIZE
    f32 = jnp.float32
    zf = z.astype(f32)
    r = zf[..., 0:W]
    k = zf[..., W:2 * W]
    v = zf[..., 2 * W:3 * W]
    o = 3 * W
    lw = zf[..., o:o + 2 * DECAY_LORA].reshape(bsz, T, 2, DECAY_LORA)
    o += 2 * DECAY_LORA
    la = zf[..., o:o + 2 * ICLR_LORA].reshape(bsz, T, 2, ICLR_LORA)
    o += 2 * ICLR_LORA
    lg = zf[..., o:o + GATE_LORA]

    w_pre = w0.astype(f32)[:, None, None, :] + jnp.einsum('btdl,dlc->dbtc', jnp.tanh(lw), w2.astype(f32))
    decay = jnp.exp(-jnp.exp(-jax.nn.softplus(-w_pre) - 0.5))
    a = jax.nn.sigmoid(a0.astype(f32)[:, None, None, :] + jnp.einsum('btdl,dlc->dbtc', la, a2.astype(f32)))
    g = jax.nn.sigmoid(lg) @ g2.astype(f32)

    heads = lambda t: t.reshape(t.shape[:-1] + (H, N))
    kk = heads(k * k_k.astype(f32))
    kk = kk / jnp.maximum(jnp.linalg.norm(kk, axis=-1, keepdims=True), 1e-12)
    kk = kk.reshape(bsz, T, W)
    k_dir = k * (1.0 + (a - 1.0) * k_a.astype(f32))
    b_dir = kk * a

    both = lambda t: jnp.stack([t, t[:, ::-1]])
    flip_bwd = lambda t: jnp.stack([t[0], t[1][:, ::-1]])
    ys = wkv7_scan(heads(both(r)), heads(flip_bwd(decay)), heads(flip_bwd(k_dir)),
                   heads(both(v)), heads(both(-kk)), heads(flip_bwd(b_dir)))
    y = ys[0] + ys[1][:, ::-1]

    mean = jnp.mean(y, axis=-1, keepdims=True)
    var = jnp.mean(jnp.square(y - mean), axis=-1, keepdims=True)
    y = ((y - mean) * lax.rsqrt(var + LNX_EPS)).reshape(bsz, T, W) * lnx_w.astype(f32) + lnx_b.astype(f32)
    bonus = jnp.einsum('dbthn,hn,bthn->bth', heads(k_dir), r_k.astype(f32), heads(r))[..., None] * heads(v)
    return ((y + bonus.reshape(bsz, T, W)) * g).astype(z.dtype)


def short_conv_mixer(zc, conv_w):
    gb = zc[..., :CONV_WIDTH]
    gc = zc[..., CONV_WIDTH:2 * CONV_WIDTH]
    u = zc[..., 2 * CONV_WIDTH:]
    cu = gc * u
    y = lax.conv_general_dilated(cu, conv_w.astype(cu.dtype)[:, None, :], window_strides=(1,),
                                 padding=[(1, 1)], dimension_numbers=('NWC', 'WIO', 'NWC'),
                                 feature_group_count=CONV_WIDTH)
    return gb * y


def moe_ffn(h, router_w, router_b, w_gu, b_gu, w_dn, b_dn):
    bsz, T, D = h.shape
    xt = h.reshape(-1, D)
    n_assign = xt.shape[0] * TOP_K
    logits = (xt @ router_w + router_b).astype(jnp.float32)
    top_val, top_idx = lax.top_k(logits, TOP_K)
    gate = jax.nn.softmax(top_val, axis=-1)

    flat_e = top_idx.reshape(-1)
    order = jnp.argsort(flat_e)
    e_sorted = flat_e[order]
    tok_sorted = (order // TOP_K).astype(jnp.int32)
    gate_sorted = gate.reshape(-1)[order]
    counts = jnp.bincount(flat_e, length=N_EXPERTS)
    padded = (counts + MOE_BLOCK - 1) // MOE_BLOCK * MOE_BLOCK
    pad_end = jnp.cumsum(padded)
    pad_start = pad_end - padded
    grp_start = jnp.cumsum(counts) - counts
    dest = pad_start[e_sorted] + jnp.arange(n_assign) - grp_start[e_sorted]
    n_blocks = -(-n_assign // MOE_BLOCK) + N_EXPERTS
    n_rows = n_blocks * MOE_BLOCK
    row_tok = jnp.zeros((n_rows,), jnp.int32).at[dest].set(tok_sorted)
    row_gate = jnp.zeros((n_rows,), jnp.float32).at[dest].set(gate_sorted)
    block_e = jnp.minimum(jnp.searchsorted(pad_end, jnp.arange(n_blocks) * MOE_BLOCK, side='right'),
                          N_EXPERTS - 1)

    def expert_block(args):
        tok, gt, e = args
        xb = xt[tok]
        gu = xb @ w_gu[e] + b_gu[e]
        gl = jnp.minimum(gu[:, :D_FF], SWIGLU_LIMIT)
        up = jnp.clip(gu[:, D_FF:], -SWIGLU_LIMIT, SWIGLU_LIMIT)
        act = (up + 1.0) * gl * jax.nn.sigmoid(SWIGLU_ALPHA * gl)
        yb = act @ w_dn[e] + b_dn[e]
        return yb * gt[:, None].astype(yb.dtype)

    yb = lax.map(expert_block, (row_tok.reshape(n_blocks, MOE_BLOCK),
                                row_gate.reshape(n_blocks, MOE_BLOCK), block_e))
    out = jnp.zeros_like(xt).at[row_tok].add(yb.reshape(n_rows, D))
    return out.reshape(bsz, T, D)


def setup_inputs(seed: int = 0) -> dict:
    key = jax.random.key(seed)
    ks = jax.random.split(key, 32)
    nrm = lambda k, shape, scale: jax.random.normal(k, shape, jnp.float32) * scale
    L, D, W = DEPTH, D_MODEL, RWKV_WIDTH
    return {
        'x': nrm(ks[0], (BATCH, SEQ, D), 1.0),
        'p': nrm(ks[1], (DEPTH, BATCH, SEQ, PLE_DIM), 1.0),
        'norm_mix_g': 1.0 + nrm(ks[2], (L, D), 0.02),
        'w_in': nrm(ks[3], (L, D, N_IN_COLS), D ** -0.5),
        'mu_shift': jax.random.uniform(ks[4], (L, N_RWKV_COLS), jnp.float32, 0.1, 0.9),
        'w0': jax.random.uniform(ks[5], (L, 2, W), jnp.float32, -5.0, 1.0),
        'w2': nrm(ks[6], (L, 2, DECAY_LORA, W), 0.1 * DECAY_LORA ** -0.5),
        'a0': nrm(ks[7], (L, 2, W), 0.1),
        'a2': nrm(ks[8], (L, 2, ICLR_LORA, W), 0.1 * ICLR_LORA ** -0.5),
        'g2': nrm(ks[9], (L, GATE_LORA, W), GATE_LORA ** -0.5),
        'k_k': 0.85 + nrm(ks[10], (L, W), 0.02),
        'k_a': 1.0 + nrm(ks[11], (L, W), 0.02),
        'r_k': nrm(ks[12], (L, RWKV_HEADS, HEAD_SIZE), 0.1),
        'lnx_w': 1.0 + nrm(ks[13], (L, W), 0.02),
        'lnx_b': nrm(ks[14], (L, W), 0.01),
        'conv_w': nrm(ks[15], (L, CONV_K, CONV_WIDTH), CONV_K ** -0.5),
        'w_out': nrm(ks[16], (L, D_MIX, D), D_MIX ** -0.5),
        'norm_ffn_g': 1.0 + nrm(ks[17], (L, D), 0.02),
        'router_w': nrm(ks[18], (L, D, N_EXPERTS), D ** -0.5),
        'router_b': nrm(ks[19], (L, N_EXPERTS), 0.01),
        'w_gu': nrm(ks[20], (L, N_EXPERTS, D, 2 * D_FF), D ** -0.5),
        'b_gu': nrm(ks[21], (L, N_EXPERTS, 2 * D_FF), 0.01),
        'w_dn': nrm(ks[22], (L, N_EXPERTS, D_FF, D), D_FF ** -0.5),
        'b_dn': nrm(ks[23], (L, N_EXPERTS, D), 0.01),
        'norm_ple_g': 1.0 + nrm(ks[24], (L, D), 0.02),
        'w_ple_gate': nrm(ks[25], (L, D, D), D ** -0.5),
        'w_ple_proj': nrm(ks[26], (L, PLE_DIM, D), PLE_DIM ** -0.5),
        'norm_final_g': 1.0 + nrm(ks[27], (D,), 0.02),
    }


def reference(x, p, norm_mix_g, w_in, mu_shift, w0, w2, a0, a2, g2, k_k, k_a, r_k, lnx_w, lnx_b,
              conv_w, w_out, norm_ffn_g, router_w, router_b, w_gu, b_gu, w_dn, b_dn,
              norm_ple_g, w_ple_gate, w_ple_proj, norm_final_g):
    for i in range(DEPTH):
        h = rms_norm(x, norm_mix_g[i])
        P = h @ w_in[i]
        zr = P[..., :N_RWKV_COLS]
        zr = zr + (centred_shift(zr) - zr) * mu_shift[i]
        y_r = rwkv7_mixer(zr, w0[i], w2[i], a0[i], a2[i], g2[i], k_k[i], k_a[i], r_k[i], lnx_w[i], lnx_b[i])
        y_c = short_conv_mixer(P[..., N_RWKV_COLS:], conv_w[i])
        x = x + jnp.concatenate([y_r, y_c], axis=-1) @ w_out[i]
        x = x + moe_ffn(rms_norm(x, norm_ffn_g[i]), router_w[i], router_b[i], w_gu[i], b_gu[i], w_dn[i], b_dn[i])
        hp = rms_norm(x, norm_ple_g[i])
        x = x + jax.nn.sigmoid(hp @ w_ple_gate[i]) * (p[i] @ w_ple_proj[i])
    return rms_norm(x, norm_final_g)
```

```cpp
#include <hip/hip_runtime.h>
#include <cstdio>
#include <cstdint>

#ifndef N_LAUNCH_MODE
#define N_LAUNCH_MODE 1
#endif

#ifndef REP_MASK
#define REP_MASK 0x0
#endif
#define LAS __attribute__((address_space(3)))
#define GAS __attribute__((address_space(1)))
typedef unsigned short bf16_t;
typedef short bf16x8 __attribute__((ext_vector_type(8)));
typedef float f32x4 __attribute__((ext_vector_type(4)));
typedef float f32x2 __attribute__((ext_vector_type(2)));
typedef unsigned u32x4 __attribute__((ext_vector_type(4)));
typedef unsigned u32x2 __attribute__((ext_vector_type(2)));
typedef int i32x8 __attribute__((ext_vector_type(8)));
typedef int i32x4 __attribute__((ext_vector_type(4)));
constexpr int FP8_SCALE_W = 0x77777777, FP8_SCALE_X = 0x7D7D7D7D;
constexpr float FP8_MUL_W = 256.0f, FP8_MUL_X = 4.0f, YB_MUL = 16.0f;

constexpr int D = 2048, NB = 4, T = 4096, M = NB * T, PLE = 256, RW = 1024, CWD = 1024, HS = 64, NH = 16;
constexpr int DL = 64, IL = 64, GL = 160, NE = 32, TOPK = 4, DFF = 2048;
constexpr int NRC = 3 * RW + 2 * DL + 2 * IL + GL;
constexpr int NIN = NRC + 3 * CWD;
constexpr int NINP = 6656;
constexpr int LK = 512, LNN = 5 * RW;
constexpr int MAXROWS = M * TOPK + NE * 256;
constexpr int MAXMT = MAXROWS / 256;
constexpr float RMS_EPS = 1e-5f, LNX_EPS = 64e-5f;
constexpr int NTHR = 512, NWAVES = 8;

constexpr size_t MiB = 1ull << 20;
constexpr size_t WS_CTL = 0, CTL_BYTES = 1 * MiB;
constexpr size_t WS_RWT = WS_CTL + 512 * 1024;
constexpr size_t WS_WIN = WS_CTL + CTL_BYTES;
constexpr size_t WS_WLORA = WS_WIN + (size_t)NINP * D * 2;
constexpr size_t WS_WOUT = WS_WLORA + (size_t)LNN * LK * 2;
constexpr size_t WS_WGU = WS_WOUT + (size_t)D * D * 2;
constexpr size_t WS_WDN = WS_WGU + (size_t)NE * 2 * DFF * D;
constexpr size_t WS_WPG = WS_WDN + (size_t)NE * D * DFF;
constexpr size_t WS_WPP = WS_WPG + (size_t)D * D * 2;
constexpr size_t WS_RWG = WS_WPP + (size_t)D * PLE * 2;
constexpr size_t WS_H = WS_RWG + (size_t)D * NE * 4;
constexpr size_t WS_PBF = WS_H + (size_t)M * D * 2;
constexpr size_t WS_P = WS_PBF + (size_t)M * PLE * 2;
constexpr size_t WS_PP = WS_P + (size_t)M * NINP * 2;
constexpr size_t WS_LA = WS_PP + (size_t)M * D * 2;
constexpr size_t WS_LOUT = WS_LA + (size_t)M * LK * 2;
constexpr size_t FRAG_BYTES = (size_t)2 * NB * NH * 64 * 16 * 512;
constexpr size_t WS_LOB = WS_LOUT + (size_t)2 * M * RW * 4;
constexpr size_t WS_BON = WS_LOUT + (size_t)M * RW * 4;
constexpr size_t WS_MF = WS_LOUT + (size_t)5 * M * RW * 4;
constexpr size_t WS_NF = WS_MF + FRAG_BYTES;
constexpr size_t WS_QF = WS_NF + FRAG_BYTES;
constexpr size_t WS_Y0F = WS_QF + FRAG_BYTES;
constexpr size_t WS_SF = WS_Y0F + FRAG_BYTES;
constexpr size_t WS_MIX = WS_SF + FRAG_BYTES;
constexpr size_t WS_X1 = WS_MIX + (size_t)M * D * 2;
constexpr size_t WS_X3 = WS_X1 + (size_t)M * D * 2;
constexpr size_t WS_H2 = WS_X1 + (size_t)M * D * 4;
constexpr size_t WS_SELE = WS_H2 + (size_t)M * D;
constexpr size_t WS_SELR = WS_SELE + (size_t)M * 4 * 4;
constexpr size_t WS_SELG = WS_SELR + (size_t)M * 4 * 4;
constexpr size_t WS_DEST = WS_SELG + (size_t)M * 4 * 4;
constexpr size_t WS_HIST = WS_DEST + (size_t)M * 4 * 4;
constexpr size_t WS_RGATE = WS_HIST + (size_t)(M / 8) * NE * 4;
constexpr size_t WS_XG = WS_RGATE + (size_t)MAXROWS * 4;
constexpr size_t WS_ACT = WS_XG + (size_t)MAXROWS * 4;
constexpr size_t WS_YB = WS_ACT + (size_t)MAXROWS * DFF;
constexpr size_t WS_X2 = WS_YB + (size_t)MAXROWS * D * 2;
constexpr size_t WS_HP = WS_X2 + (size_t)M * D * 4;
constexpr size_t WS_END = WS_HP + (size_t)M * D * 2;
static_assert(WS_END <= 4096ull * MiB, "workspace map must fit 4 GiB");
static_assert(WS_WIN % 256 == 0 && WS_RWG % 256 == 0 && WS_XG % 256 == 0 && WS_RGATE % 256 == 0, "alignment");

constexpr int CW_BAR = 0;
constexpr int CW_CNT = 4096;

constexpr int LDS_STAGE = 131072;
constexpr int LDS_BARW = LDS_STAGE;
constexpr int LDS_TAB = LDS_STAGE + 64;
constexpr int LDS_ROWT = LDS_STAGE + 4096;
constexpr int ROWT_UNITS = 18;
constexpr int LDS_BYTES = LDS_ROWT + ROWT_UNITS * 1024;

struct Prm { const float* in[28]; float* out; unsigned char* ws; };

__device__ __forceinline__ unsigned f2bf(float f) { unsigned u = __float_as_uint(f); return (u + 0x7fffu + ((u >> 16) & 1u)) >> 16; }
typedef __bf16 bfv2_t __attribute__((ext_vector_type(2)));
typedef _Float16 hv2_t __attribute__((ext_vector_type(2)));
__device__ __forceinline__ unsigned pkh2(float lo, float hi) { const f32x2 v = (f32x2){lo, hi}; const hv2_t h = __builtin_convertvector(v, hv2_t); return __builtin_bit_cast(unsigned, h); }
__device__ __forceinline__ f32x2 unpkh2(unsigned w) { return __builtin_convertvector(__builtin_bit_cast(hv2_t, w), f32x2); }
__device__ __forceinline__ unsigned pk2(float lo, float hi) { const f32x2 v = (f32x2){lo, hi}; const bfv2_t b = __builtin_convertvector(v, bfv2_t); return __builtin_bit_cast(unsigned, b); }
__device__ __forceinline__ float bf_lo(unsigned w) { return __uint_as_float(w << 16); }
__device__ __forceinline__ float bf_hi(unsigned w) { return __uint_as_float(w & 0xffff0000u); }
__device__ __forceinline__ unsigned cvt_pk_bf16(float lo, float hi) { unsigned r; asm volatile("v_cvt_pk_bf16_f32 %0, %1, %2" : "=v"(r) : "v"(lo), "v"(hi)); return r; }
__device__ __forceinline__ unsigned pk4_fp8(float a, float b, float c, float d) {
    a = fminf(fmaxf(a, -448.f), 448.f); b = fminf(fmaxf(b, -448.f), 448.f); c = fminf(fmaxf(c, -448.f), 448.f); d = fminf(fmaxf(d, -448.f), 448.f);
    unsigned r = 0u; r = __builtin_amdgcn_cvt_pk_fp8_f32(a, b, r, false); r = __builtin_amdgcn_cvt_pk_fp8_f32(c, d, r, true); return r; }
__device__ __forceinline__ unsigned pk4_fp8w(float a, float b, float c, float d) {
    unsigned r = 0u; r = __builtin_amdgcn_cvt_pk_fp8_f32(a, b, r, false); r = __builtin_amdgcn_cvt_pk_fp8_f32(c, d, r, true); return r; }
__device__ __forceinline__ float wave_sum(float v) {
#pragma unroll
    for (int o = 1; o < 64; o <<= 1) v += __shfl_xor(v, o);
    return v;
}
__device__ __forceinline__ float sigmoidf_(float x) { return __builtin_amdgcn_rcpf(1.0f + __expf(-x)); }
#define LDS_WAIT() asm volatile("s_waitcnt lgkmcnt(0)" ::: "memory")
#define VM_WAIT() asm volatile("s_waitcnt vmcnt(0)" ::: "memory")
__device__ __forceinline__ void unpack8(const u32x4 w, float* o) { o[0] = bf_lo(w.x); o[1] = bf_hi(w.x); o[2] = bf_lo(w.y); o[3] = bf_hi(w.y); o[4] = bf_lo(w.z); o[5] = bf_hi(w.z); o[6] = bf_lo(w.w); o[7] = bf_hi(w.w); }
__device__ __forceinline__ void load16bf(const bf16_t* p, bool valid, float* o) {
    u32x4 a = (u32x4){0u, 0u, 0u, 0u}, b = a;
    if (valid) { a = *(const u32x4*)p; b = *(const u32x4*)(p + 8); }
    unpack8(a, o); unpack8(b, o + 8);
}
__device__ __forceinline__ void load16f(const float* p, float* o) {
#pragma unroll
    for (int i = 0; i < 4; ++i) { const f32x4 v = *(const f32x4*)(p + 4 * i); o[4 * i] = v.x; o[4 * i + 1] = v.y; o[4 * i + 2] = v.z; o[4 * i + 3] = v.w; }
}
__device__ __forceinline__ void store16f(float* p, const float* o) {
#pragma unroll
    for (int i = 0; i < 4; ++i) *(f32x4*)(p + 4 * i) = (f32x4){o[4 * i], o[4 * i + 1], o[4 * i + 2], o[4 * i + 3]};
}

namespace pg8 {
constexpr int BM = 256, BK = 64, HALF = 128, HTB = HALF * BK * 2, STAGE_BYTES = 8 * HTB, NXCD = 8, WGM = 8;
__host__ __device__ __forceinline__ int lds_byte(int r, int c) { const int st = (r >> 4) * 2 + (c >> 5), rr = r & 15, cc = c & 31, ob = rr * 64 + cc * 2; return st * 1024 + (ob ^ (((ob >> 9) & 1) << 5)); }
__host__ __device__ __forceinline__ void stage_rc(int b, int& R, int& C) { const int st = b / 1024, sb = b % 1024, swz = sb ^ (((sb >> 9) & 1) << 5); R = (st >> 1) * 16 + swz / 64; C = (st & 1) * 32 + (swz % 64) / 2; }
__host__ __device__ __forceinline__ int perm32(int rho) { const int n = rho >> 4, i = rho & 15; return 8 * (i >> 2) + 4 * n + (i & 3); }
__host__ __device__ __forceinline__ int perm128(int R) { return 64 * (R >> 5) + 16 * ((R >> 2) & 3) + 4 * ((R >> 4) & 1) + (R & 3); }

struct Unit { int pm, pn, e; };

struct Order {
    int nM, nN, nwg, G, c, lo, hi; const LAS int* blk_e;
    __device__ void init(int nM_, int nN_, int G_, int c_, const LAS int* be) { nM = nM_; nN = nN_; nwg = nM * nN; G = G_; c = c_; blk_e = be; lo = 0; hi = 0x7fffffff; }
    __device__ bool next(int i, Unit& u) const {
        if (i + lo >= hi) return false;
        const long L = (long)(i + lo) * G + c; if (L >= nwg) return false;
        int wgid = (int)L; { const int q = nwg / NXCD, r = nwg % NXCD, xcd = wgid % NXCD, off = wgid / NXCD; wgid = (xcd < r ? xcd * (q + 1) : r * (q + 1) + (xcd - r) * q) + off; }
        const int nig = WGM * nN, gid = wgid / nig, fm = gid * WGM, gsz = (nM - fm) < WGM ? (nM - fm) : WGM;
        u.pm = fm + ((wgid % nig) % gsz); u.pn = (wgid % nig) / gsz;
        u.e = blk_e ? __builtin_amdgcn_readfirstlane(blk_e[u.pm]) : 0;
        return true;
    }
};

template <class Prob, bool ALIGN_EPI, bool FP8 = false, bool GATHER = false>
__device__ __forceinline__ void gemm_phase(LAS unsigned char* lds, const Prob& P, const Order& S, const LAS unsigned* rowtab = nullptr) {
    int tid_ = threadIdx.x; asm volatile("" : "+v"(tid_));
    const int tid = tid_, wid = __builtin_amdgcn_readfirstlane(tid >> 6), lane = tid & 63, wr = wid >> 2, wc = wid & 3, fr = lane & 15, fq = lane >> 4;
    const int K = P.K, nt = P.kloop() / BK;
    unsigned voffA[2], voffB[2]; int gR[2]; unsigned gC[2]; unsigned vgc[2][2], vgn[2][2];
#pragma unroll
    for (int i = 0; i < 2; ++i) { int R, C; stage_rc(tid * 16 + i * 8192, R, C); const int Rb = ((int)Prob::PERM == 2) ? perm128(R) : (Prob::PERM ? ((R & ~31) + perm32(R & 31)) : R);
        voffA[i] = (unsigned)(R * K + C) * 2u; voffB[i] = (unsigned)(Rb * K + C) * 2u; gR[i] = R; gC[i] = (unsigned)C * 2u; }
#define PG8_GLOAD(dst, uidx) do { if constexpr (GATHER) { _Pragma("unroll") for (int h_ = 0; h_ < 2; ++h_) _Pragma("unroll") for (int i_ = 0; i_ < 2; ++i_) dst[h_][i_] = rowtab[(uidx) * 256 + h_ * 128 + gR[i_]] + gC[i_]; } } while (0)
    const size_t kstep = (size_t)(BK * 2);
    const size_t hstep = (size_t)HALF * K * 2;
    const size_t hstepB = ((int)Prob::PERM == 2) ? (size_t)8 * K * 2 : hstep;
    const unsigned ldsw = (unsigned)wid * 1024u;
    const int aoff = lds_byte(wr * 64 + fr, fq * 8), boff = lds_byte(wc * 32 + fr, fq * 8);
#define PG8_SA(b, h) (((b) * 2 + (h)) * HTB)
#define PG8_SB(b, h) ((4 + (b) * 2 + (h)) * HTB)
#define PG8_STAGE(bufoff, gbase, voff) do { _Pragma("unroll") for (int _i = 0; _i < 2; ++_i) \
        __builtin_amdgcn_global_load_lds((const unsigned*)((const char*)(gbase) + (voff)[_i]), (LAS unsigned*)(lds + (bufoff) + ldsw + _i * 8192), 16, 0, 0); } while (0)
#define PG8_STAGE_A(bufoff, kbase, H, nx) do { _Pragma("unroll") for (int _i = 0; _i < 2; ++_i) { \
        const unsigned vo_ = GATHER ? ((nx) ? vgn[H][_i] : vgc[H][_i]) : voffA[_i]; \
        __builtin_amdgcn_global_load_lds((const unsigned*)((const char*)(kbase) + (GATHER ? (size_t)0 : hstep * (H)) + vo_), (LAS unsigned*)(lds + (bufoff) + ldsw + _i * 8192), 16, 0, 0); } } while (0)
#define PG8_LDA(dst, b, h) do { _Pragma("unroll") for (int m = 0; m < 4; ++m) { const i32x4 lo_ = *(const LAS i32x4*)(lds + PG8_SA(b, h) + aoff + m * 2048), hi_ = *(const LAS i32x4*)(lds + PG8_SA(b, h) + aoff + m * 2048 + 1024); dst[m] = __builtin_shufflevector(lo_, hi_, 0, 1, 2, 3, 4, 5, 6, 7); } } while (0)
#define PG8_LDB(dst, b, h) do { _Pragma("unroll") for (int n = 0; n < 2; ++n) { const i32x4 lo_ = *(const LAS i32x4*)(lds + PG8_SB(b, h) + boff + n * 2048), hi_ = *(const LAS i32x4*)(lds + PG8_SB(b, h) + boff + n * 2048 + 1024); dst[n] = __builtin_shufflevector(lo_, hi_, 0, 1, 2, 3, 4, 5, 6, 7); } } while (0)
#define PG8_H0(v) __builtin_bit_cast(bf16x8, __builtin_shufflevector(v, v, 0, 1, 2, 3))
#define PG8_H1(v) __builtin_bit_cast(bf16x8, __builtin_shufflevector(v, v, 4, 5, 6, 7))
#define PG8_MMA(ai, bj, At, Bt) do { __builtin_amdgcn_s_setprio(1); _Pragma("unroll") for (int m = 0; m < 4; ++m) _Pragma("unroll") for (int n = 0; n < 2; ++n) { \
        acc[ai][bj][m][n] = __builtin_amdgcn_mfma_f32_16x16x32_bf16(PG8_H0(Bt[n]), PG8_H0(At[m]), acc[ai][bj][m][n], 0, 0, 0); \
        acc[ai][bj][m][n] = __builtin_amdgcn_mfma_f32_16x16x32_bf16(PG8_H1(Bt[n]), PG8_H1(At[m]), acc[ai][bj][m][n], 0, 0, 0); } __builtin_amdgcn_s_setprio(0); } while (0)
#define PG8_MMA8(ai, bj, At, Bt) do { __builtin_amdgcn_s_setprio(1); _Pragma("unroll") for (int m = 0; m < 4; ++m) _Pragma("unroll") for (int n = 0; n < 2; ++n) \
        asm volatile("v_mfma_scale_f32_16x16x128_f8f6f4 %0, %1, %2, %0, %3, %4 op_sel_hi:[0,0,0]" : "+v"(acc[ai][bj][m][n]) : "v"(Bt[n]), "v"(At[m]), "v"(fp8_sw), "v"(fp8_sx)); __builtin_amdgcn_s_setprio(0); } while (0)
#define PG8_MM(ai, bj, At, Bt) do { if constexpr (FP8) PG8_MMA8(ai, bj, At, Bt); else PG8_MMA(ai, bj, At, Bt); } while (0)
#define PG8_WAIT_V(n) asm volatile("s_waitcnt vmcnt(" #n ")" ::: "memory")
#define PG8_WAIT_L(n) asm volatile("s_waitcnt lgkmcnt(" #n ")" ::: "memory")
#define PG8_BAR __builtin_amdgcn_s_barrier()
#define PG8_SCHED __builtin_amdgcn_sched_barrier(0)
    Unit cur, nxt; int ui = 0;
    if (!S.next(0, cur)) return;
    f32x4 acc[2][2][4][2];
#pragma unroll
    for (int a = 0; a < 2; ++a)
#pragma unroll
        for (int b = 0; b < 2; ++b)
#pragma unroll
            for (int m = 0; m < 4; ++m)
#pragma unroll
                for (int n = 0; n < 2; ++n) acc[a][b][m][n] = (f32x4){0.f, 0.f, 0.f, 0.f};
    i32x8 At[4], B0[2], B1[2]; const int fp8_sw = FP8_SCALE_W, fp8_sx = FP8_SCALE_X; (void)fp8_sw; (void)fp8_sx;
    const char* cA = P.Aptr(cur); const char* cB = P.Bptr(cur);
    PG8_GLOAD(vgc, 0); PG8_GLOAD(vgn, 0);
    PG8_STAGE(PG8_SB(0, 0), cB, voffB); PG8_STAGE(PG8_SB(0, 1), cB + hstepB, voffB); PG8_STAGE_A(PG8_SA(0, 0), cA, 0, false); PG8_STAGE_A(PG8_SA(0, 1), cA, 1, false);
    if (wr == 1) PG8_BAR;
    PG8_WAIT_V(2); PG8_BAR;
    PG8_STAGE(PG8_SB(1, 0), cB + kstep, voffB); PG8_STAGE_A(PG8_SA(1, 0), cA + kstep, 0, false); PG8_STAGE(PG8_SB(1, 1), cB + hstepB + kstep, voffB);
    PG8_WAIT_V(6); PG8_BAR;
    for (;;) {
        const bool has_next = S.next(ui + 1, nxt);
        if (has_next) PG8_GLOAD(vgn, ui + 1);
        const char* nA = has_next ? P.Aptr(nxt) : cA; const char* nB = has_next ? P.Bptr(nxt) : cB;
        for (int t = 0; t < nt; t += 2) {
            const bool last = (t == nt - 2);
            const char* a1 = cA + (size_t)(t + 1) * kstep;
            const char* a2 = last ? nA : cA + (size_t)(t + 2) * kstep; const char* b2 = last ? nB : cB + (size_t)(t + 2) * kstep;
            const char* a3 = a2 + kstep; const char* b3 = b2 + kstep;
            PG8_LDB(B0, 0, 0); PG8_LDB(B1, 0, 1); PG8_SCHED; PG8_LDA(At, 0, 0); PG8_STAGE_A(PG8_SA(1, 1), a1, 1, false);
            PG8_WAIT_V(8); PG8_WAIT_L(0); PG8_BAR; PG8_MM(0, 0, At, B0); PG8_MM(0, 1, At, B1); PG8_BAR; PG8_SCHED;
            PG8_LDA(At, 0, 1); PG8_STAGE(PG8_SB(0, 0), b2, voffB); PG8_STAGE(PG8_SB(0, 1), b2 + hstepB, voffB); PG8_STAGE_A(PG8_SA(0, 0), a2, 0, last);
            PG8_WAIT_V(8); PG8_WAIT_L(0); PG8_BAR; PG8_MM(1, 0, At, B0); PG8_MM(1, 1, At, B1); PG8_BAR; PG8_SCHED;
            PG8_LDB(B0, 1, 0); PG8_LDB(B1, 1, 1); PG8_SCHED; PG8_LDA(At, 1, 0); PG8_STAGE_A(PG8_SA(0, 1), a2, 1, last);
            PG8_WAIT_V(8); PG8_WAIT_L(0); PG8_BAR; PG8_MM(0, 0, At, B0); PG8_MM(0, 1, At, B1); PG8_BAR; PG8_SCHED;
            PG8_LDA(At, 1, 1); PG8_STAGE(PG8_SB(1, 0), b3, voffB); PG8_STAGE(PG8_SB(1, 1), b3 + hstepB, voffB); PG8_STAGE_A(PG8_SA(1, 0), a3, 0, last);
            PG8_WAIT_V(8); PG8_WAIT_L(0); PG8_BAR; PG8_MM(1, 0, At, B0); PG8_MM(1, 1, At, B1); PG8_BAR; PG8_SCHED;
        }
        if constexpr (ALIGN_EPI) { if (wr == 0) PG8_BAR; }
        { int fr_ = fr, fq_ = fq; asm volatile("" : "+v"(fr_), "+v"(fq_)); P.epi(acc, cur, wr, wc, fr_, fq_); }
        if (!has_next) break;
#pragma unroll
        for (int a = 0; a < 2; ++a)
#pragma unroll
            for (int b = 0; b < 2; ++b)
#pragma unroll
                for (int m = 0; m < 4; ++m)
#pragma unroll
                    for (int n = 0; n < 2; ++n) acc[a][b][m][n] = (f32x4){0.f, 0.f, 0.f, 0.f};
        cur = nxt; cA = nA; cB = nB; ++ui;
        if constexpr (GATHER) { _Pragma("unroll") for (int h_ = 0; h_ < 2; ++h_) _Pragma("unroll") for (int i_ = 0; i_ < 2; ++i_) vgc[h_][i_] = vgn[h_][i_]; }
        if constexpr (ALIGN_EPI) { if (wr == 1) PG8_BAR; }
    }
    PG8_WAIT_V(0);
    if constexpr (!ALIGN_EPI) { if (wr == 0) PG8_BAR; }
    PG8_BAR;
#undef PG8_SA
#undef PG8_SB
#undef PG8_STAGE
#undef PG8_STAGE_A
#undef PG8_GLOAD
#undef PG8_LDA
#undef PG8_LDB
#undef PG8_MMA
#undef PG8_H0
#undef PG8_H1
#undef PG8_MMA8
#undef PG8_MM
#undef PG8_WAIT_V
#undef PG8_WAIT_L
#undef PG8_BAR
#undef PG8_SCHED
}
}
using pg8::Unit;
typedef const f32x4 (&AccRef)[2][2][4][2];

struct ProbBf16 {
    static constexpr bool PERM = true;
    const bf16_t* A; const bf16_t* Bt; bf16_t* O; int K, ldc;
    __device__ __forceinline__ int kloop() const { return K; }
    __device__ __forceinline__ const char* Aptr(const Unit& u) const { return (const char*)A + (size_t)u.pm * 256 * K * 2; }
    __device__ __forceinline__ const char* Bptr(const Unit& u) const { return (const char*)Bt + (size_t)u.pn * 256 * K * 2; }
    __device__ __forceinline__ void epi(AccRef acc, const Unit& u, int wr, int wc, int fr, int fq) const {
        const int row0 = u.pm * 256 + wr * 64 + fr, col0 = u.pn * 256 + wc * 32 + 8 * fq;
#pragma unroll
        for (int ai = 0; ai < 2; ++ai)
#pragma unroll
            for (int m = 0; m < 4; ++m) { bf16_t* rowp = O + (size_t)(row0 + ai * 128 + m * 16) * ldc + col0;
#pragma unroll
                for (int bj = 0; bj < 2; ++bj) { const f32x4 v0 = acc[ai][bj][m][0], v1 = acc[ai][bj][m][1];
                    u32x4 w; w.x = cvt_pk_bf16(v0[0], v0[1]); w.y = cvt_pk_bf16(v0[2], v0[3]); w.z = cvt_pk_bf16(v1[0], v1[1]); w.w = cvt_pk_bf16(v1[2], v1[3]);
                    *(u32x4*)(rowp + bj * 128) = w; } }
    }
};
struct ProbLora {
    static constexpr bool PERM = true;
    const bf16_t* A; const bf16_t* Bt; float* O; const float* w0; const float* a0; int K;
    __device__ __forceinline__ int kloop() const { int kl = 256; asm volatile("" : "+s"(kl)); return kl; }
    __device__ __forceinline__ const char* Aptr(const Unit& u) const { return (const char*)A + (size_t)u.pm * 256 * K * 2 + ((u.pn >> 2) == 4 ? 512 : 0); }
    __device__ __forceinline__ const char* Bptr(const Unit& u) const { return (const char*)Bt + (size_t)u.pn * 256 * K * 2 + ((u.pn >> 2) == 4 ? 512 : 0); }
    __device__ __forceinline__ void epi(AccRef acc, const Unit& u, int wr, int wc, int fr, int fq) const {
        const int type = u.pn >> 2, cb = (u.pn & 3) * 256 + wc * 32 + 8 * fq, row0 = u.pm * 256 + wr * 64 + fr;
        const float* bias = type < 2 ? w0 + type * RW : (type < 4 ? a0 + (type - 2) * RW : nullptr);
        float* Ob = O + (size_t)type * M * RW; bf16_t* Ob16 = (bf16_t*)(O + (size_t)2 * M * RW) + (size_t)(type - 2) * M * RW;
#pragma unroll
        for (int bj = 0; bj < 2; ++bj) { const int c = cb + bj * 128;
            const f32x4 z = (f32x4){0.f, 0.f, 0.f, 0.f}; const f32x4 bv0 = bias ? *(const f32x4*)(bias + c) : z, bv1 = bias ? *(const f32x4*)(bias + c + 4) : z;
#pragma unroll
            for (int ai = 0; ai < 2; ++ai)
#pragma unroll
                for (int m = 0; m < 4; ++m) { f32x4 v0 = acc[ai][bj][m][0] + bv0, v1 = acc[ai][bj][m][1] + bv1; const size_t ro = (size_t)(row0 + ai * 128 + m * 16) * RW + c;
                    if (type < 2) {
#pragma unroll
                        for (int j = 0; j < 4; ++j) { v0[j] = -0.60653066f * sigmoidf_(v0[j]); v1[j] = -0.60653066f * sigmoidf_(v1[j]); }
                        *(u32x4*)((unsigned short*)O + (size_t)type * M * RW + ro) = (u32x4){pkh2(v0[0], v0[1]), pkh2(v0[2], v0[3]), pkh2(v1[0], v1[1]), pkh2(v1[2], v1[3])};
                    } else {
                        if (type < 4) {
#pragma unroll
                            for (int j = 0; j < 4; ++j) { v0[j] = sigmoidf_(v0[j]); v1[j] = sigmoidf_(v1[j]); } }
                        *(u32x4*)(Ob16 + ro) = (u32x4){cvt_pk_bf16(v0[0], v0[1]), cvt_pk_bf16(v0[2], v0[3]), cvt_pk_bf16(v1[0], v1[1]), cvt_pk_bf16(v1[2], v1[3])}; } } }
    }
};
struct ProbRes {
    static constexpr bool PERM = true;
    const bf16_t* A; const bf16_t* Bt; const float* base; bf16_t* O; int K;
    __device__ __forceinline__ int kloop() const { return K; }
    __device__ __forceinline__ const char* Aptr(const Unit& u) const { return (const char*)A + (size_t)u.pm * 256 * K * 2; }
    __device__ __forceinline__ const char* Bptr(const Unit& u) const { return (const char*)Bt + (size_t)u.pn * 256 * K * 2; }
    __device__ __forceinline__ void epi(AccRef acc, const Unit& u, int wr, int wc, int fr, int fq) const {
        const int row0 = u.pm * 256 + wr * 64 + fr, col0 = u.pn * 256 + wc * 32 + 8 * fq;
#pragma unroll
        for (int ai = 0; ai < 2; ++ai)
#pragma unroll
            for (int m = 0; m < 4; ++m) { const size_t off = (size_t)(row0 + ai * 128 + m * 16) * D + col0;
#pragma unroll
                for (int bj = 0; bj < 2; ++bj) { const float* bp = base + off + bj * 128; const f32x4 r0 = *(const f32x4*)bp + acc[ai][bj][m][0], r1 = *(const f32x4*)(bp + 4) + acc[ai][bj][m][1];
                    *(u32x4*)(O + off + bj * 128) = (u32x4){cvt_pk_bf16(r0[0], r0[1]), cvt_pk_bf16(r0[2], r0[3]), cvt_pk_bf16(r1[0], r1[1]), cvt_pk_bf16(r1[2], r1[3])}; } }
    }
};
struct ProbGU {
    static constexpr bool PERM = true;
    const bf16_t* A; const bf16_t* Bt; bf16_t* O; const float* bgu; int K;
    __device__ __forceinline__ int kloop() const { return K; }
    __device__ __forceinline__ const char* Aptr(const Unit&) const { return (const char*)A; }
    __device__ __forceinline__ const char* Bptr(const Unit& u) const { return (const char*)Bt + ((size_t)u.e * 2 * DFF + (size_t)u.pn * 256) * K * 2; }
    __device__ __forceinline__ void epi(AccRef acc, const Unit& u, int wr, int wc, int fr, int fq) const {
        const int row0 = u.pm * 256 + wr * 64 + fr, f0 = u.pn * 128 + wc * 32 + 8 * fq;
        const float* bg = bgu + (size_t)u.e * 2 * DFF + f0;
        const f32x4 bgl0 = *(const f32x4*)bg, bgl1 = *(const f32x4*)(bg + 4), bup0 = *(const f32x4*)(bg + DFF), bup1 = *(const f32x4*)(bg + DFF + 4);
#pragma unroll
        for (int ai = 0; ai < 2; ++ai)
#pragma unroll
            for (int m = 0; m < 4; ++m) {
                float o[8];
#pragma unroll
                for (int n = 0; n < 2; ++n) { const f32x4 g4 = acc[ai][0][m][n] + (n ? bgl1 : bgl0), u4 = acc[ai][1][m][n] + (n ? bup1 : bup0);
#pragma unroll
                    for (int j = 0; j < 4; ++j) { const float gl = fminf(g4[j], 7.0f), up = fminf(fmaxf(u4[j], -7.0f), 7.0f);
                        o[4 * n + j] = (up + 1.0f) * gl * sigmoidf_(1.702f * gl); } }
                u32x2 w; w.x = pk4_fp8w(o[0] * FP8_MUL_X, o[1] * FP8_MUL_X, o[2] * FP8_MUL_X, o[3] * FP8_MUL_X); w.y = pk4_fp8w(o[4] * FP8_MUL_X, o[5] * FP8_MUL_X, o[6] * FP8_MUL_X, o[7] * FP8_MUL_X);
                *(u32x2*)((unsigned char*)O + (size_t)(row0 + ai * 128 + m * 16) * DFF + f0) = w; }
    }
};
struct ProbDN {
    static constexpr int PERM = 2;
    const bf16_t* A; const bf16_t* Bt; bf16_t* O; const float* bdn; const float* rgate; int K;
    __device__ __forceinline__ int kloop() const { return K; }
    __device__ __forceinline__ const char* Aptr(const Unit& u) const { return (const char*)A + (size_t)u.pm * 256 * K * 2; }
    __device__ __forceinline__ const char* Bptr(const Unit& u) const { return (const char*)Bt + ((size_t)u.e * D + (size_t)u.pn * 256) * K * 2; }
    __device__ __forceinline__ void epi(AccRef acc, const Unit& u, int wr, int wc, int fr, int fq) const {
        const int row0 = u.pm * 256 + wr * 64 + fr, col0 = u.pn * 256 + wc * 64 + 16 * fq;
        const float* bb = bdn + (size_t)u.e * D + col0;
        f32x4 bv[2][2];
#pragma unroll
        for (int bj = 0; bj < 2; ++bj)
#pragma unroll
            for (int n = 0; n < 2; ++n) bv[bj][n] = *(const f32x4*)(bb + bj * 8 + 4 * n);
#pragma unroll
        for (int ai = 0; ai < 2; ++ai)
#pragma unroll
            for (int m = 0; m < 4; ++m) { const int row = row0 + ai * 128 + m * 16; const float gt = rgate[row] * YB_MUL; unsigned char* rowp = (unsigned char*)O + (size_t)row * D + col0;
                u32x4 w;
#pragma unroll
                for (int bj = 0; bj < 2; ++bj) { const f32x4 v0 = (acc[ai][bj][m][0] + bv[bj][0]) * gt, v1 = (acc[ai][bj][m][1] + bv[bj][1]) * gt;
                    w[2 * bj] = pk4_fp8(v0[0], v0[1], v0[2], v0[3]); w[2 * bj + 1] = pk4_fp8(v1[0], v1[1], v1[2], v1[3]); }
                *(u32x4*)rowp = w; }
    }
};
struct ProbPLE {
    static constexpr bool PERM = true;
    const bf16_t* A; const bf16_t* Bt; const bf16_t* x2; const bf16_t* pp; bf16_t* O; int K;
    __device__ __forceinline__ int kloop() const { return K; }
    __device__ __forceinline__ const char* Aptr(const Unit& u) const { return (const char*)A + (size_t)u.pm * 256 * K * 2; }
    __device__ __forceinline__ const char* Bptr(const Unit& u) const { return (const char*)Bt + (size_t)u.pn * 256 * K * 2; }
    __device__ __forceinline__ void epi(AccRef acc, const Unit& u, int wr, int wc, int fr, int fq) const {
        const int row0 = u.pm * 256 + wr * 64 + fr, col0 = u.pn * 256 + wc * 32 + 8 * fq;
#pragma unroll
        for (int ai = 0; ai < 2; ++ai)
#pragma unroll
            for (int m = 0; m < 4; ++m) { const size_t off = (size_t)(row0 + ai * 128 + m * 16) * D + col0;
#pragma unroll
                for (int bj = 0; bj < 2; ++bj) { const size_t o = off + bj * 128; float xb[8], pv[8], r[8]; unpack8(*(const u32x4*)(x2 + o), xb); unpack8(*(const u32x4*)(pp + o), pv);
#pragma unroll
                    for (int n = 0; n < 2; ++n)
#pragma unroll
                        for (int j = 0; j < 4; ++j) r[4 * n + j] = xb[4 * n + j] + sigmoidf_(acc[ai][bj][m][n][j]) * pv[4 * n + j];
                    *(u32x4*)(O + o) = (u32x4){cvt_pk_bf16(r[0], r[1]), cvt_pk_bf16(r[2], r[3]), cvt_pk_bf16(r[4], r[5]), cvt_pk_bf16(r[6], r[7])}; } }
    }
};

#define XB_TMO      128
#define XB_XCNT(j)  (256  + 64 * (j))
#define XB_XSUB(j)  (1280 + 64 * (j))
#define XB_XGEN(j)  (2304 + 64 * (j))
#define XB_TOP      3328
#define XB_TOPGEN   3392
#define XCD_BAR_WORDS 3456
#define XB_SPIN_CAP (1u << 18)
__device__ __forceinline__ unsigned xb_ld(unsigned* p)              { return __hip_atomic_load(p, __ATOMIC_RELAXED, __HIP_MEMORY_SCOPE_AGENT); }
__device__ __forceinline__ unsigned xb_add(unsigned* p, unsigned v) { return __hip_atomic_fetch_add(p, v, __ATOMIC_RELAXED, __HIP_MEMORY_SCOPE_AGENT); }
__device__ __forceinline__ unsigned xb_xcc_id() { return (unsigned)__builtin_amdgcn_s_getreg((3 << 11) | 20) & 0xFu; }
#define XB_SPIN(cond, bar) do { unsigned _sp = 0; while (cond) { __builtin_amdgcn_s_sleep(1); \
    if ((++_sp & 255u) == 0u) { if (xb_ld(&(bar)[XB_TMO])) break; if (_sp > XB_SPIN_CAP) { atomicAdd(&(bar)[XB_TMO], 1u); break; } } } } while (0)
struct XcdBarrier { unsigned* bar; unsigned x; volatile LAS unsigned* st; };
__device__ __forceinline__ XcdBarrier xcd_barrier_post(unsigned* bar, volatile LAS unsigned* st) {
    XcdBarrier b; b.bar = bar; b.x = xb_xcc_id(); b.st = st;
    if (threadIdx.x == 0) (void)xb_add(&bar[XB_XCNT(b.x)], 1u);
    return b;
}
__device__ __forceinline__ void xcd_barrier_complete(unsigned* bar, unsigned x, unsigned& nloc, unsigned& nx) {
    const unsigned G = gridDim.x * gridDim.y * gridDim.z;
    unsigned sum, cnt, mine, sp = 0u;
    for (;;) {
        sum = 0u; cnt = 0u; mine = 0u;
#pragma unroll
        for (unsigned j = 0; j < 16; ++j) { const unsigned c = xb_ld(&bar[XB_XCNT(j)]); sum += c; cnt += (c > 0u) ? 1u : 0u; mine = (j == x) ? c : mine; }
        if (sum == G) break;
        __builtin_amdgcn_s_sleep(1);
        if ((++sp & 255u) == 0u) { if (xb_ld(&bar[XB_TMO])) break; if (sp > XB_SPIN_CAP) { atomicAdd(&bar[XB_TMO], 1u); break; } }
    }
    nloc = mine > 0u ? mine : 1u; nx = cnt > 0u ? cnt : 1u;
}
__device__ __forceinline__ void xcd_barrier(const XcdBarrier& b) {
    asm volatile("s_waitcnt vmcnt(0)" ::: "memory");
    __syncthreads();
    if (threadIdx.x == 0) {
        unsigned* bar = b.bar;
        __builtin_amdgcn_s_waitcnt(0);
        unsigned nloc = b.st[0], nx = b.st[1];
        if (nloc == 0u) { xcd_barrier_complete(bar, b.x, nloc, nx); b.st[0] = nloc; b.st[1] = nx; }
        const unsigned old = xb_add(&bar[XB_XSUB(b.x)], 1u);
        const unsigned gen = old / nloc;
        if (old + 1u == (gen + 1u) * nloc) {
            __builtin_amdgcn_fence(__ATOMIC_RELEASE, "agent");
            asm volatile("s_waitcnt vmcnt(0)" ::: "memory");
            const unsigned og = xb_add(&bar[XB_TOP], 1u);
            const unsigned tg = og / nx;
            if (og + 1u == (tg + 1u) * nx) xb_add(&bar[XB_TOPGEN], 1u);
            else XB_SPIN(xb_ld(&bar[XB_TOPGEN]) == tg, bar);
            __builtin_amdgcn_fence(__ATOMIC_ACQUIRE, "agent");
            xb_add(&bar[XB_XGEN(b.x)], 1u);
            asm volatile("s_waitcnt vmcnt(0)" ::: "memory");
        } else {
            XB_SPIN(xb_ld(&bar[XB_XGEN(b.x)]) == gen, bar);
            __builtin_amdgcn_fence(__ATOMIC_ACQUIRE, "agent");
            asm volatile("s_waitcnt vmcnt(0)" ::: "memory");
        }
    }
    __syncthreads();
}

struct Ctx { LAS unsigned char* lds; int tid, lane, wave, vb, nvb; };

__device__ __forceinline__ void transpose_item(const float* W, int N, bf16_t* WT, int ldk, int drow0, LAS float* scr, int k0, int n0, int lane) {
    float vv[32]; const float* wp = W + (size_t)(k0 + (lane >> 5)) * N + n0 + (lane & 31);
#pragma unroll
    for (int i = 0; i < 32; ++i) vv[i] = wp[(size_t)(2 * i) * N];
#pragma unroll
    for (int i = 0; i < 32; ++i) scr[(2 * i + (lane >> 5)) * 33 + (lane & 31)] = vv[i];
    LDS_WAIT(); asm volatile("" ::: "memory");
    const int c = lane & 7;
#pragma unroll
    for (int j = 0; j < 4; ++j) { const int n = (lane >> 3) + 8 * j; const LAS float* s = scr + (8 * c) * 33 + n;
        u32x4 o; o.x = pk2(s[0 * 33], s[1 * 33]); o.y = pk2(s[2 * 33], s[3 * 33]); o.z = pk2(s[4 * 33], s[5 * 33]); o.w = pk2(s[6 * 33], s[7 * 33]);
        *(u32x4*)(WT + (size_t)(drow0 + n) * ldk + k0 + 8 * c) = o; }
    LDS_WAIT(); asm volatile("" ::: "memory");
}
__device__ __forceinline__ void transpose_item8(const float* W, int N, unsigned char* WT, int ldk, int drow0, LAS float* scr, int k0, int n0, int lane) {
    float vv[32]; const float* wp = W + (size_t)(k0 + (lane >> 5)) * N + n0 + (lane & 31);
#pragma unroll
    for (int i = 0; i < 32; ++i) vv[i] = wp[(size_t)(2 * i) * N];
#pragma unroll
    for (int i = 0; i < 32; ++i) scr[(2 * i + (lane >> 5)) * 33 + (lane & 31)] = vv[i] * FP8_MUL_W;
    LDS_WAIT(); asm volatile("" ::: "memory");
    const int c = lane & 7;
#pragma unroll
    for (int j = 0; j < 4; ++j) { const int n = (lane >> 3) + 8 * j; const LAS float* s = scr + (8 * c) * 33 + n;
        u32x2 o; o.x = pk4_fp8w(s[0 * 33], s[1 * 33], s[2 * 33], s[3 * 33]); o.y = pk4_fp8w(s[4 * 33], s[5 * 33], s[6 * 33], s[7 * 33]);
        *(u32x2*)(WT + (size_t)(drow0 + n) * ldk + k0 + 8 * c) = o; }
    LDS_WAIT(); asm volatile("" ::: "memory");
}
__device__ __forceinline__ void rms_row_bf16(const float* xrow, const float* g, bf16_t* orow, int lane) {
    const f32x4* xr = (const f32x4*)xrow + lane; f32x4 v[8]; float s = 0.f;
#pragma unroll
    for (int j = 0; j < 8; ++j) { v[j] = xr[64 * j]; s += (v[j].x * v[j].x + v[j].y * v[j].y) + (v[j].z * v[j].z + v[j].w * v[j].w); }
    const float rstd = 1.0f / sqrtf(wave_sum(s) * (1.0f / D) + RMS_EPS);
    unsigned long long* o8 = (unsigned long long*)orow + lane;
#pragma unroll
    for (int j = 0; j < 8; ++j) { const f32x4 gg = ((const f32x4*)g)[lane + 64 * j];
        o8[64 * j] = (unsigned long long)pk2(v[j].x * rstd * gg.x, v[j].y * rstd * gg.y) | ((unsigned long long)pk2(v[j].z * rstd * gg.z, v[j].w * rstd * gg.w) << 32); }
}

namespace cv {
constexpr int I_IN = (D / 128) * (NIN / 32);
constexpr int I_OUT = (D / 128) * (D / 32);
constexpr int I_GU1 = (D / 128) * (2 * DFF / 32);
constexpr int I_DN1 = (DFF / 128) * (D / 32);
constexpr int I_PG = I_OUT;
constexpr int I_PP = (PLE / 128) * (D / 32);
constexpr int NITEMS = I_IN + I_OUT + NE * I_GU1 + NE * I_DN1 + I_PG + I_PP;
constexpr int EXP_A = I_IN + I_OUT;
#ifndef CONV_MOVED
#define CONV_MOVED 98304
#endif
constexpr int MOVED = CONV_MOVED;
static_assert(MOVED <= NE * (I_GU1 + I_DN1), "moved items are expert items");
struct ItemD { const float* src; size_t rs; unsigned char* dst; int ldk; int f8; };
__device__ __forceinline__ void decode(const Prm& p, int lane, int it, ItemD& d) {
    unsigned char* ws = p.ws; int r = it; const int l5 = lane >> 5, l31 = lane & 31;
    if (r < I_IN) { const int nblk = NIN / 32, kb = r / nblk, nb = r % nblk; d.src = p.in[3] + (size_t)(128 * kb + l5) * NIN + 32 * nb + l31; d.rs = (size_t)2 * NIN; d.dst = ws + WS_WIN + ((size_t)(32 * nb) * D + 128 * kb) * 2; d.ldk = D * 2; d.f8 = 0; return; } r -= I_IN;
    if (r < I_OUT) { const int nblk = D / 32, kb = r / nblk, nb = r % nblk; d.src = p.in[16] + (size_t)(128 * kb + l5) * D + 32 * nb + l31; d.rs = (size_t)2 * D; d.dst = ws + WS_WOUT + ((size_t)(32 * nb) * D + 128 * kb) * 2; d.ldk = D * 2; d.f8 = 0; return; } r -= I_OUT;
    if (r < NE * I_GU1) { const int e = r / I_GU1, q = r % I_GU1, nblk = 2 * DFF / 32, kb = q / nblk, nb = q % nblk, n0 = 32 * nb;
        const int bj = n0 / DFF, j = n0 % DFF, pn = j / 128, cc = j % 128, drow0 = pn * 256 + bj * 128 + cc;
        d.src = p.in[20] + (size_t)e * D * 2 * DFF + (size_t)(128 * kb + l5) * (2 * DFF) + n0 + l31; d.rs = (size_t)4 * DFF; d.dst = ws + WS_WGU + (size_t)e * 2 * DFF * D + (size_t)drow0 * D + 128 * kb; d.ldk = D; d.f8 = 1; return; } r -= NE * I_GU1;
    if (r < NE * I_DN1) { const int e = r / I_DN1, q = r % I_DN1, nblk = D / 32, kb = q / nblk, nb = q % nblk;
        d.src = p.in[22] + (size_t)e * DFF * D + (size_t)(128 * kb + l5) * D + 32 * nb + l31; d.rs = (size_t)2 * D; d.dst = ws + WS_WDN + (size_t)e * D * DFF + (size_t)(32 * nb) * DFF + 128 * kb; d.ldk = DFF; d.f8 = 1; return; } r -= NE * I_DN1;
    if (r < I_PG) { const int nblk = D / 32, kb = r / nblk, nb = r % nblk; d.src = p.in[25] + (size_t)(128 * kb + l5) * D + 32 * nb + l31; d.rs = (size_t)2 * D; d.dst = ws + WS_WPG + (size_t)(32 * nb) * D + 128 * kb; d.ldk = D; d.f8 = 1; return; } r -= I_PG;
    { const int nblk = D / 32, kb = r / nblk, nb = r % nblk; d.src = p.in[26] + (size_t)(128 * kb + l5) * D + 32 * nb + l31; d.rs = (size_t)2 * D; d.dst = ws + WS_WPP + ((size_t)(32 * nb) * PLE + 128 * kb) * 2; d.ldk = PLE * 2; d.f8 = 0; }
}
__device__ __forceinline__ void loop(const Prm& p, const Ctx& c, int q0, int nq, int qs, int skipA, int skip) {
    LAS float* scr = (LAS float*)(c.lds + c.wave * 16384);
#define CV_IT(q_) ((q_) + ((q_) >= skipA ? skip : 0))
    if (q0 < nq) {
        ItemD cur; decode(p, c.lane, CV_IT(q0), cur); float va[2][32];
#pragma unroll
        for (int h = 0; h < 2; ++h)
#pragma unroll
            for (int i = 0; i < 32; ++i) va[h][i] = __builtin_nontemporal_load(cur.src + (size_t)(32 * h + i) * cur.rs);
        for (int q = q0; q < nq; q += qs) {
            const bool more = q + qs < nq; ItemD nxt = cur; float vb[2][32];
            if (more) { decode(p, c.lane, CV_IT(q + qs), nxt);
#pragma unroll
                for (int h = 0; h < 2; ++h)
#pragma unroll
                    for (int i = 0; i < 32; ++i) vb[h][i] = __builtin_nontemporal_load(nxt.src + (size_t)(32 * h + i) * nxt.rs); }
            const float mul = cur.f8 ? FP8_MUL_W : 1.0f;
#pragma unroll
            for (int h = 0; h < 2; ++h) {
#pragma unroll
                for (int i = 0; i < 32; ++i) scr[(2 * i + (c.lane >> 5)) * 33 + (c.lane & 31)] = va[h][i] * mul;
                LDS_WAIT(); asm volatile("" ::: "memory");
                { const int cc = c.lane & 7;
#pragma unroll
                  for (int j = 0; j < 4; ++j) { const int n = (c.lane >> 3) + 8 * j; const LAS float* sp = scr + (8 * cc) * 33 + n;
                      const float t0 = sp[0 * 33], t1 = sp[1 * 33], t2 = sp[2 * 33], t3 = sp[3 * 33], t4 = sp[4 * 33], t5 = sp[5 * 33], t6 = sp[6 * 33], t7 = sp[7 * 33];
                      if (cur.f8) { u32x2 o; o.x = pk4_fp8w(t0, t1, t2, t3); o.y = pk4_fp8w(t4, t5, t6, t7); *(u32x2*)(cur.dst + (size_t)n * cur.ldk + 64 * h + 8 * cc) = o; }
                      else { u32x4 o; o.x = pk2(t0, t1); o.y = pk2(t2, t3); o.z = pk2(t4, t5); o.w = pk2(t6, t7); *(u32x4*)(cur.dst + (size_t)n * cur.ldk + 128 * h + 16 * cc) = o; } } }
                LDS_WAIT(); asm volatile("" ::: "memory");
            }
            if (more) { cur = nxt;
#pragma unroll
                for (int h = 0; h < 2; ++h)
#pragma unroll
                    for (int i = 0; i < 32; ++i) va[h][i] = vb[h][i]; }
        }
    }
#undef CV_IT
}
constexpr int RUN_GU = NE * I_GU1;
constexpr int RUN_DN = NE * I_DN1;
constexpr int NRUN = RUN_GU + RUN_DN;
#ifndef CW1
#define CW1 6
#define CW2 14
#define CW3 3
#define CW7 3
#endif
#ifndef PA_CONV
#define PA_CONV 1
#endif
constexpr int SLOT_BASE = PA_CONV ? NE * I_GU1 : 0;
constexpr int P1_NU = (M / 256) * (NINP / 256);
__device__ __forceinline__ void slot_split(int nvb, int vb, int& moved, int& start, int& cnt) {
    const int numax = (P1_NU + nvb - 1) / nvb, r = P1_NU - (numax - 1) * nvb, total = (r * CW1 + (nvb - r) * CW2) * NWAVES;
    moved = SLOT_BASE + total < NE * (I_GU1 + I_DN1) ? SLOT_BASE + total : NE * (I_GU1 + I_DN1);
    start = SLOT_BASE + (vb < r ? vb * CW1 : r * CW1 + (vb - r) * CW2) * NWAVES; cnt = vb < r ? CW1 : CW2;
}
__device__ __forceinline__ int slot_total(int nvb) { int m1, s_, c_; slot_split(nvb, 0, m1, s_, c_); const int t = m1 + nvb * NWAVES * (CW3 + CW7); return t < NE * (I_GU1 + I_DN1) ? t : NE * (I_GU1 + I_DN1); }

struct SubD { const f32x4* src; unsigned char* dst; int rs4; };
__device__ __forceinline__ void sub_decode(const Prm& p, int lane, int r, SubD& d) {
    unsigned char* ws = p.ws; const int kq = lane >> 3, nq = lane & 7;
    if (r < RUN_GU) { const int e = r / I_GU1, q = r % I_GU1, nblk = 2 * DFF / 32, kb = q / nblk, nb = q % nblk, n0 = 32 * nb, k0 = 128 * kb + 16 * kq;
        const int bj = n0 / DFF, j = (n0 % DFF) + 4 * nq, drow = (j >> 7) * 256 + bj * 128 + (j & 127);
        d.src = (const f32x4*)(p.in[20] + (size_t)e * D * 2 * DFF + (size_t)k0 * (2 * DFF) + n0 + 4 * nq); d.rs4 = 2 * DFF / 4;
        d.dst = ws + WS_WGU + (size_t)e * 2 * DFF * D + (size_t)drow * D + k0; }
    else { const int r2 = r - RUN_GU, e = r2 / I_DN1, q = r2 % I_DN1, nblk = D / 32, kb = q / nblk, nb = q % nblk, n0 = 32 * nb, k0 = 128 * kb + 16 * kq;
        d.src = (const f32x4*)(p.in[22] + (size_t)e * DFF * D + (size_t)k0 * D + n0 + 4 * nq); d.rs4 = D / 4;
        d.dst = ws + WS_WDN + (size_t)e * D * DFF + (size_t)(n0 + 4 * nq) * DFF + k0; }
}
__device__ __forceinline__ void stream8(const Prm& p, const Ctx& c, int w0, int nw, int run_lo, int run_hi) {
    const int span = run_hi - run_lo; if (w0 >= span) return;
    const int n = (span - w0 + nw - 1) / nw;
    f32x4 A[16], B[16], C[16]; SubD dA, dB, dC;
#define CV_ISSUE(BUF, DD, t_) do { sub_decode(p, c.lane, __builtin_amdgcn_readfirstlane(run_lo + w0 + (t_) * nw), DD); _Pragma("unroll") for (int i = 0; i < 16; ++i) BUF[i] = __builtin_nontemporal_load(DD.src + (size_t)i * DD.rs4); } while (0)
#define CV_Q(BUF, i0, ee) pk4_fp8w(BUF[i0][ee] * FP8_MUL_W, BUF[i0 + 1][ee] * FP8_MUL_W, BUF[i0 + 2][ee] * FP8_MUL_W, BUF[i0 + 3][ee] * FP8_MUL_W)
#define CV_CONSUME(BUF, DD) do { _Pragma("unroll") for (int ee = 0; ee < 4; ++ee) { u32x4 o; o.x = CV_Q(BUF, 0, ee); o.y = CV_Q(BUF, 4, ee); o.z = CV_Q(BUF, 8, ee); o.w = CV_Q(BUF, 12, ee); \
        *(u32x4*)(DD.dst + (size_t)ee * D) = o; } } while (0)
    int t = 0;
    if (n >= 5) {
        CV_ISSUE(A, dA, 0); CV_ISSUE(B, dB, 1);
#pragma unroll 1
        for (; t + 4 < n; t += 3) {
            CV_ISSUE(C, dC, t + 2); CV_CONSUME(A, dA);
            CV_ISSUE(A, dA, t + 3); CV_CONSUME(B, dB);
            CV_ISSUE(B, dB, t + 4); CV_CONSUME(C, dC);
        }
    } else { CV_ISSUE(A, dA, 0); if (n > 1) CV_ISSUE(B, dB, 1); }
#pragma unroll 1
    for (; t < n; t += 3) {
        if (t + 2 < n) CV_ISSUE(C, dC, t + 2);
        CV_CONSUME(A, dA);
        if (t + 1 < n) { if (t + 3 < n) CV_ISSUE(A, dA, t + 3); CV_CONSUME(B, dB); }
        if (t + 2 < n) { if (t + 4 < n) CV_ISSUE(B, dB, t + 4); CV_CONSUME(C, dC); }
    }
#undef CV_ISSUE
#undef CV_Q
#undef CV_CONSUME
}
}

__device__ __forceinline__ void ph_prologue(const Prm& p, const Ctx& c) {
    unsigned char* ws = p.ws;
    const int gw = c.vb * NWAVES + c.wave, NGW = c.nvb * NWAVES;
    cv::loop(p, c, gw, cv::NITEMS - NE * (cv::I_GU1 + cv::I_DN1), NGW, cv::EXP_A, NE * (cv::I_GU1 + cv::I_DN1));
    cv::stream8(p, c, gw, NGW, cv::slot_total(c.nvb), cv::NRUN);
    const int gt = c.vb * NTHR + c.tid, NGT = c.nvb * NTHR;
    { u32x4* z = (u32x4*)((bf16_t*)(ws + WS_WIN) + (size_t)NIN * D); const int n16 = (NINP - NIN) * D * 2 / 16;
      for (int i = gt; i < n16; i += NGT) z[i] = (u32x4){0u, 0u, 0u, 0u}; }
    { unsigned* o = (unsigned*)(ws + WS_WLORA); const float *w2 = p.in[6], *a2 = p.in[8], *g2 = p.in[9];
      for (int i = gt; i < LNN * LK / 2; i += NGT) { const int n = i / (LK / 2), k = (i % (LK / 2)) * 2, type = n >> 10, cc = n & 1023; float v0 = 0.f, v1 = 0.f;
          if (type == 0 && k < 64) { v0 = w2[(size_t)k * RW + cc]; v1 = w2[(size_t)(k + 1) * RW + cc]; }
          else if (type == 1 && k >= 64 && k < 128) { v0 = w2[(size_t)(64 + k - 64) * RW + cc]; v1 = w2[(size_t)(64 + k - 63) * RW + cc]; }
          else if (type == 2 && k >= 128 && k < 192) { v0 = a2[(size_t)(k - 128) * RW + cc]; v1 = a2[(size_t)(k - 127) * RW + cc]; }
          else if (type == 3 && k >= 192 && k < 256) { v0 = a2[(size_t)(64 + k - 192) * RW + cc]; v1 = a2[(size_t)(64 + k - 191) * RW + cc]; }
          else if (type == 4 && k >= 256 && k < 416) { v0 = g2[(size_t)(k - 256) * RW + cc]; v1 = g2[(size_t)(k - 255) * RW + cc]; }
          o[i] = pk2(v0, v1); } }
    { bf16_t* o = (bf16_t*)(ws + WS_RWT); const float *rw = p.in[18], *g = p.in[17];
      for (int i = gt; i < D * NE; i += NGT) { const int k = i >> 5, e = i & 31; const float wv = rw[i] * g[k];
          const unsigned h0 = f2bf(wv); const float r1 = wv - __uint_as_float(h0 << 16); const unsigned h1 = f2bf(r1); const float r2 = r1 - __uint_as_float(h1 << 16); const unsigned h2 = f2bf(r2);
          o[(size_t)e * D + k] = (bf16_t)h0; o[(size_t)(NE + e) * D + k] = (bf16_t)h1; o[(size_t)(2 * NE + e) * D + k] = (bf16_t)h2; } }
    { const f32x4* s = (const f32x4*)p.in[1]; u32x2* o = (u32x2*)(ws + WS_PBF);
      for (int i = gt; i < M * PLE / 4; i += NGT) { const f32x4 v = s[i]; o[i] = (u32x2){pk2(v.x, v.y), pk2(v.z, v.w)}; } }
    for (int m = gw; m < M; m += NGW) rms_row_bf16(p.in[0] + (size_t)m * D, p.in[2], (bf16_t*)(ws + WS_H) + (size_t)m * D, c.lane);
}

__device__ __forceinline__ void ph_gemm_in(const Prm& p, const Ctx& c) {
    unsigned char* ws = p.ws;
    { ProbBf16 P{(const bf16_t*)(ws + WS_H), (const bf16_t*)(ws + WS_WIN), (bf16_t*)(ws + WS_P), D, NINP};
      pg8::Order S; S.init(M / 256, NINP / 256, c.nvb, c.vb, nullptr);
      constexpr int NU = cv::P1_NU;
      const int nu = c.vb < NU ? (NU - 1 - c.vb) / c.nvb + 1 : 0;
      int moved, cstart, ccnt; cv::slot_split(c.nvb, c.vb, moved, cstart, ccnt);
      int spos = (c.vb >> 3) & 7; if (spos > nu) spos = nu;
#pragma unroll 1
      for (int seg = 0; seg < 2; ++seg) {
          S.lo = seg ? spos : 0; S.hi = seg ? nu : spos;
          pg8::gemm_phase<ProbBf16, true>(c.lds, P, S);
          if (seg == 0) {
              const int b0 = cstart + c.wave * ccnt, b1 = b0 + ccnt < moved ? b0 + ccnt : moved;
              int one = 1; asm volatile("" : "+s"(one));
              cv::stream8(p, c, 0, one, b0, b1);
              VM_WAIT(); __syncthreads();
          }
      } }
    { ProbBf16 P{(const bf16_t*)(ws + WS_PBF), (const bf16_t*)(ws + WS_WPP), (bf16_t*)(ws + WS_PP), PLE, D};
      pg8::Order S; S.init(M / 256, D / 256, c.nvb, c.vb, nullptr); pg8::gemm_phase<ProbBf16, true>(c.lds, P, S); }
}

__device__ __forceinline__ void ph_lora_in(const Prm& p, const Ctx& c) {
    unsigned char* ws = p.ws; const bf16_t* Pm = (const bf16_t*)(ws + WS_P); bf16_t* LA = (bf16_t*)(ws + WS_LA); const float* mu = p.in[4];
    const int gw = c.vb * NWAVES + c.wave, NGW = c.nvb * NWAVES, cc = c.lane * 8;
    float mm[8] = {0.f, 0.f, 0.f, 0.f, 0.f, 0.f, 0.f, 0.f};
    if (cc < 416) { const f32x4 m0 = *(const f32x4*)(mu + 3 * RW + cc), m1 = *(const f32x4*)(mu + 3 * RW + cc + 4); mm[0] = m0.x; mm[1] = m0.y; mm[2] = m0.z; mm[3] = m0.w; mm[4] = m1.x; mm[5] = m1.y; mm[6] = m1.z; mm[7] = m1.w; }
    for (int tok0 = gw; tok0 < M; tok0 += 4 * NGW) {
        u32x4 ra[4], rp[4], rn[4]; const u32x4 z4 = (u32x4){0u, 0u, 0u, 0u};
#pragma unroll
        for (int q = 0; q < 4; ++q) { const int tok = tok0 + q * NGW; ra[q] = z4; rp[q] = z4; rn[q] = z4;
            if (tok < M && cc < 416) { const int t = tok % T; const bf16_t* row = Pm + (size_t)tok * NINP + 3 * RW + cc;
                ra[q] = *(const u32x4*)row; if (t > 0) rp[q] = *(const u32x4*)(row - NINP); if (t < T - 1) rn[q] = *(const u32x4*)(row + NINP); } }
#pragma unroll
        for (int q = 0; q < 4; ++q) { const int tok = tok0 + q * NGW; if (tok >= M) break;
            float a[8], pm[8], pn[8], z[8]; unpack8(ra[q], a); unpack8(rp[q], pm); unpack8(rn[q], pn);
#pragma unroll
            for (int i = 0; i < 8; ++i) { z[i] = a[i] + (0.5f * (pm[i] + pn[i]) - a[i]) * mm[i];
                if (cc < 128) z[i] = 2.0f * sigmoidf_(2.0f * z[i]) - 1.0f;
                else if (cc >= 256) z[i] = sigmoidf_(z[i]); }
            u32x4 o = (u32x4){pk2(z[0], z[1]), pk2(z[2], z[3]), pk2(z[4], z[5]), pk2(z[6], z[7])};
            if (cc >= 416) o = z4;
            *(u32x4*)(LA + (size_t)tok * LK + cc) = o; }
    }
}

template <class Prob>
__device__ __forceinline__ void gemm_with_slot(const Prm& p, const Ctx& c, const Prob& P, pg8::Order& S, int nunits, int spos, int off, int cw) {
    const int nu = c.vb < nunits ? (nunits - 1 - c.vb) / c.nvb + 1 : 0; if (spos > nu) spos = nu;
    const int lim = NE * (cv::I_GU1 + cv::I_DN1);
#pragma unroll 1
    for (int seg = 0; seg < 2; ++seg) {
        S.lo = seg ? spos : 0; S.hi = seg ? nu : spos;
        pg8::gemm_phase<Prob, true>(c.lds, P, S);
        if (seg == 0 && cw > 0) {
            int b0 = off + (c.vb * NWAVES + c.wave) * cw, b1 = b0 + cw; if (b0 > lim) b0 = lim; if (b1 > lim) b1 = lim;
            int one = 1; asm volatile("" : "+s"(one));
            cv::stream8(p, c, 0, one, b0, b1);
            VM_WAIT(); __syncthreads();
        }
    }
}
__device__ __forceinline__ void ph_gemm_lora(const Prm& p, const Ctx& c) {
    unsigned char* ws = p.ws;
    ProbLora P{(const bf16_t*)(ws + WS_LA), (const bf16_t*)(ws + WS_WLORA), (float*)(ws + WS_LOUT), p.in[5], p.in[7], LK};
    pg8::Order S; S.init(M / 256, LNN / 256, c.nvb, c.vb, nullptr);
    { int m1, s_, c_; cv::slot_split(c.nvb, c.vb, m1, s_, c_); gemm_with_slot<ProbLora>(p, c, P, S, (M / 256) * (LNN / 256), (c.vb >> 3) % 6, m1, CW3); }
}

typedef short bf16x4 __attribute__((ext_vector_type(4)));
typedef __bf16 bfv4_t __attribute__((ext_vector_type(4)));
__device__ __forceinline__ bf16x4 pack4(const f32x4 v) { const bfv4_t b = __builtin_convertvector(v, bfv4_t); return __builtin_bit_cast(bf16x4, b); }
__device__ __forceinline__ f32x4 unpack4(const bf16x4 b) { const u32x2 w = __builtin_bit_cast(u32x2, b); return (f32x4){bf_lo(w.x), bf_hi(w.x), bf_lo(w.y), bf_hi(w.y)}; }
__device__ __forceinline__ bf16x8 cat8(const bf16x4 lo, const bf16x4 hi) { return __builtin_shufflevector(lo, hi, 0, 1, 2, 3, 4, 5, 6, 7); }
__device__ __forceinline__ f32x4 mfma32(const bf16x8 a, const bf16x8 b, const f32x4 c) {
    f32x4 d; asm volatile("s_nop 1\n\tv_mfma_f32_16x16x32_bf16 %0, %1, %2, %3\n\ts_nop 7" : "=&v"(d) : "v"(a), "v"(b), "v"(c)); return d; }

constexpr int CRS = 144;
constexpr int L_AT = 0, L_BT = 9216, L_KT = 18432, L_RT = 27648;
constexpr int L_AF = 36864, L_BHF = 45056, L_KHF = 53248, L_VF = 61440;
constexpr int L_MAB = 69632, L_MAK = 78848, L_MRB = 88064, L_MRK = 97280;
constexpr int L_MTI = 106496;
constexpr int L_GL = 109568;
constexpr int L_TOT = 109824;
static_assert(L_TOT + 4096 <= LDS_STAGE, "chunk LDS map");

__device__ __forceinline__ float zshift(float a, float pm, float pn, float mu) { return a + (0.5f * (pm + pn) - a) * mu; }
__device__ __forceinline__ void ph_chunk_pre(const Prm& p, const Ctx& c) {
    unsigned char* ws = p.ws; const bf16_t* Pm = (const bf16_t*)(ws + WS_P); const float* mu = p.in[4]; const unsigned short* LOUT = (const unsigned short*)(ws + WS_LOUT); const bf16_t* LOB = (const bf16_t*)(ws + WS_LOB);
    LAS unsigned char* lds = c.lds;
    const int lane = c.lane, m16 = lane & 15, g = lane >> 4, w = c.wave;
    const int tq = c.tid >> 5, kp = c.tid & 31, k0 = 2 * kp;
    const bf16x4 zero4 = (bf16x4){0, 0, 0, 0};
    unsigned Lp[6], Lk[6], Lv[6], Lap[4], Llp[4], Lap1[4];
#define PA_ISSUE(it_) do { const int h_ = (it_) & 15, ch_ = ((it_) >> 4) & 63, b_ = ((it_) >> 10) & 3, d_ = (it_) >> 12; \
        const int col_ = h_ * HS + k0, pos0_ = 64 * ch_ + 4 * tq, ttf_ = d_ ? (T - 1 - (pos0_ + 3)) : pos0_; \
        _Pragma("unroll") for (int rho = 0; rho < 6; ++rho) { const int tt = ttf_ - 1 + rho; unsigned a_ = 0u, b2_ = 0u, c2_ = 0u; \
            if (tt >= 0 && tt < T) { const bf16_t* row = Pm + (size_t)(b_ * T + tt) * NINP + col_; a_ = *(const unsigned*)row; b2_ = *(const unsigned*)(row + RW); c2_ = *(const unsigned*)(row + 2 * RW); } \
            Lp[rho] = a_; Lk[rho] = b2_; Lv[rho] = c2_; } \
        _Pragma("unroll") for (int e = 0; e < 4; ++e) { const int tte = d_ ? (ttf_ + 3 - e) : (ttf_ + e); const size_t o_ = (size_t)(b_ * T + tte) * RW + col_; \
            Lap[e] = *(const unsigned*)(LOB + (size_t)d_ * M * RW + o_); Lap1[e] = d_ ? 0u : *(const unsigned*)(LOB + (size_t)M * RW + o_); Llp[e] = *(const unsigned*)(LOUT + (size_t)d_ * M * RW + o_); } } while (0)
    if (c.vb < 2 * NB * NH * 64) PA_ISSUE(c.vb);
#if PA_CONV
    f32x4 CA[16]; cv::SubD cd;
#endif
    for (int item = c.vb; item < 2 * NB * NH * 64; item += c.nvb) {
        const int h = item & 15, ch = (item >> 4) & 63, b = (item >> 10) & 3, d = item >> 12;
        {
            const int col = h * HS + k0, pos0 = 64 * ch + 4 * tq;
            const int tt_first = d ? (T - 1 - (pos0 + 3)) : pos0;
            float rr[6][2], kr[6][2], vr[6][2];
#pragma unroll
            for (int rho = 0; rho < 6; ++rho) { const unsigned a = Lp[rho], bq = Lk[rho], cq = Lv[rho];
                rr[rho][0] = bf_lo(a); rr[rho][1] = bf_hi(a); kr[rho][0] = bf_lo(bq); kr[rho][1] = bf_hi(bq); vr[rho][0] = bf_lo(cq); vr[rho][1] = bf_hi(cq); }
            const f32x2 mr = *(const f32x2*)(mu + col), mk = *(const f32x2*)(mu + RW + col), mv = *(const f32x2*)(mu + 2 * RW + col);
            const f32x2 kkw = *(const f32x2*)(p.in[10] + col), kaw = *(const f32x2*)(p.in[11] + col);
            float re[4][2], ke[4][2], ve[4][2], as[4][2], lwv[4][2];
#pragma unroll
            for (int e = 0; e < 4; ++e) {
                const f32x2 a2 = (f32x2){bf_lo(Lap[e]), bf_hi(Lap[e])}, l2 = unpkh2(Llp[e]);
                as[e][0] = a2.x; as[e][1] = a2.y; lwv[e][0] = l2.x; lwv[e][1] = l2.y;
#pragma unroll
                for (int j = 0; j < 2; ++j) {
                    const float rc = d ? rr[4 - e][j] : rr[e + 1][j], rs = d ? (rr[3 - e][j] + rr[5 - e][j]) : (rr[e][j] + rr[e + 2][j]);
                    const float kc = d ? kr[4 - e][j] : kr[e + 1][j], ks = d ? (kr[3 - e][j] + kr[5 - e][j]) : (kr[e][j] + kr[e + 2][j]);
                    const float vc = d ? vr[4 - e][j] : vr[e + 1][j], vs = d ? (vr[3 - e][j] + vr[5 - e][j]) : (vr[e][j] + vr[e + 2][j]);
                    re[e][j] = rc + (0.5f * rs - rc) * (j ? mr.y : mr.x); ke[e][j] = kc + (0.5f * ks - kc) * (j ? mk.y : mk.x); ve[e][j] = vc + (0.5f * vs - vc) * (j ? mv.y : mv.x);
                }
            }
            if (d == 0) { const f32x2 rkw = *(const f32x2*)(p.in[12] + col); float* BON = (float*)(ws + WS_BON);
#pragma unroll
                for (int e = 0; e < 4; ++e) { const float a1x = bf_lo(Lap1[e]), a1y = bf_hi(Lap1[e]);
                    float bp = ke[e][0] * (2.0f + (as[e][0] + a1x - 2.0f) * kaw.x) * rkw.x * re[e][0] + ke[e][1] * (2.0f + (as[e][1] + a1y - 2.0f) * kaw.y) * rkw.y * re[e][1];
                    bp += __shfl_xor(bp, 1); bp += __shfl_xor(bp, 2); bp += __shfl_xor(bp, 4); bp += __shfl_xor(bp, 8); bp += __shfl_xor(bp, 16);
                    if (kp == 0) BON[(size_t)(b * T + pos0 + e) * NH + h] = bp; } }
            float kk[4][2];
#pragma unroll
            for (int e = 0; e < 4; ++e) { kk[e][0] = ke[e][0] * kkw.x; kk[e][1] = ke[e][1] * kkw.y; float n2 = kk[e][0] * kk[e][0] + kk[e][1] * kk[e][1];
                n2 += __shfl_xor(n2, 1); n2 += __shfl_xor(n2, 2); n2 += __shfl_xor(n2, 4); n2 += __shfl_xor(n2, 8); n2 += __shfl_xor(n2, 16);
                const float inv = __builtin_amdgcn_rsqf(fmaxf(n2, 1e-24f)); kk[e][0] *= inv; kk[e][1] *= inv; }
            float pre[4][2];
#pragma unroll
            for (int j = 0; j < 2; ++j) { pre[0][j] = lwv[0][j]; pre[1][j] = pre[0][j] + lwv[1][j]; pre[2][j] = pre[1][j] + lwv[2][j]; pre[3][j] = pre[2][j] + lwv[3][j]; }
            LAS float* tot = (LAS float*)(lds + L_TOT);
            *(LAS f32x2*)(tot + tq * 64 + k0) = (f32x2){pre[3][0], pre[3][1]};
            __syncthreads();
            float offs[2] = {0.f, 0.f}, lgl[2] = {0.f, 0.f};
#pragma unroll
            for (int q = 0; q < 16; ++q) { const f32x2 tv = *(const LAS f32x2*)(tot + q * 64 + k0); lgl[0] += tv.x; lgl[1] += tv.y; if (q < tq) { offs[0] += tv.x; offs[1] += tv.y; } }
            float At[4][2], Bh[4][2], Kh[4][2];
#pragma unroll
            for (int e = 0; e < 4; ++e) {
                const int tau = 4 * tq + e; float bt[2], kt[2], rt[2];
#pragma unroll
                for (int j = 0; j < 2; ++j) {
                    const float lG = offs[j] + pre[e][j], lGp = lG - lwv[e][j];
                    const float kaj = j ? kaw.y : kaw.x;
                    const float kd = ke[e][j] * (1.0f + (as[e][j] - 1.0f) * kaj), bd = kk[e][j] * as[e][j];
                    const float eg = __expf(lG), eng = __expf(-lG), elg = __expf(lgl[j] - lG);
                    At[e][j] = -kk[e][j] * __expf(lGp); bt[j] = bd * eng; kt[j] = kd * eng; rt[j] = re[e][j] * eg; Bh[e][j] = bd * elg; Kh[e][j] = kd * elg;
                }
                *(LAS unsigned*)(lds + L_AT + tau * CRS + k0 * 2) = pk2(At[e][0], At[e][1]);
                *(LAS unsigned*)(lds + L_BT + tau * CRS + k0 * 2) = pk2(bt[0], bt[1]);
                *(LAS unsigned*)(lds + L_KT + tau * CRS + k0 * 2) = pk2(kt[0], kt[1]);
                *(LAS unsigned*)(lds + L_RT + tau * CRS + k0 * 2) = pk2(rt[0], rt[1]);
            }
#pragma unroll
            for (int j = 0; j < 2; ++j) { const int x = k0 + j; const int fo = ((tq >> 2) * 4 + (x >> 4)) * 512 + ((x & 15) + 16 * (tq & 3)) * 8;
                *(LAS u32x2*)(lds + L_AF + fo) = (u32x2){pk2(At[0][j], At[1][j]), pk2(At[2][j], At[3][j])};
                *(LAS u32x2*)(lds + L_BHF + fo) = (u32x2){pk2(Bh[0][j], Bh[1][j]), pk2(Bh[2][j], Bh[3][j])};
                *(LAS u32x2*)(lds + L_KHF + fo) = (u32x2){pk2(Kh[0][j], Kh[1][j]), pk2(Kh[2][j], Kh[3][j])};
                *(LAS u32x2*)(lds + L_VF + fo) = (u32x2){pk2(ve[0][j], ve[1][j]), pk2(ve[2][j], ve[3][j])};
                if (tq == 0) ((LAS float*)(lds + L_GL))[x] = __expf(lgl[j]); }
        }
        if (item + c.nvb < 2 * NB * NH * 64) PA_ISSUE(item + c.nvb);
#if PA_CONV
        cv::sub_decode(p, lane, __builtin_amdgcn_readfirstlane(item * NWAVES + w), cd);
#pragma unroll
        for (int i = 0; i < 16; ++i) CA[i] = __builtin_nontemporal_load(cd.src + (size_t)i * cd.rs4);
#endif
        __syncthreads();
#pragma unroll 1
        for (int tix = w; tix < 40; tix += 8) {
            const int pidx = tix >> 2, mat = tix & 3;
            const int i = pidx < 1 ? 0 : (pidx < 3 ? 1 : (pidx < 6 ? 2 : 3)), j = pidx - (i * (i + 1)) / 2;
            const int abase = (mat < 2 ? L_AT : L_RT) + (16 * i + m16) * CRS + 16 * g, bbase = ((mat & 1) ? L_KT : L_BT) + (16 * j + m16) * CRS + 16 * g;
            f32x4 acc = (f32x4){0.f, 0.f, 0.f, 0.f};
            acc = mfma32(*(const LAS bf16x8*)(lds + abase), *(const LAS bf16x8*)(lds + bbase), acc);
            acc = mfma32(*(const LAS bf16x8*)(lds + abase + 64), *(const LAS bf16x8*)(lds + bbase + 64), acc);
            const int tcol = 16 * j + m16; LAS unsigned char* mo = lds + L_MAB + mat * 9216 + tcol * 2;
#pragma unroll
            for (int jj = 0; jj < 4; ++jj) { const int trow = 16 * i + 4 * g + jj; const bool keep = (mat < 2) ? (tcol < trow) : (tcol <= trow);
                *(LAS unsigned short*)(mo + trow * CRS) = (unsigned short)f2bf(keep ? acc[jj] : 0.f); }
        }
        __syncthreads();
        if (w == 0) {
            const int blk = g, cc = m16; float t[16];
#pragma unroll
            for (int r = 0; r < 16; ++r) {
                const LAS unsigned char* rowp = lds + L_MAB + (16 * blk + r) * CRS + 32 * blk; float a[16];
                unpack8(*(const LAS u32x4*)rowp, a); unpack8(*(const LAS u32x4*)(rowp + 16), a + 8);
                float s = (r == cc) ? 1.0f : 0.0f;
#pragma unroll
                for (int q = 0; q < r; ++q) s += a[q] * t[q];
                t[r] = s;
                *(LAS unsigned short*)(lds + L_MTI + (16 * blk + r) * 48 + cc * 2) = (unsigned short)f2bf(s);
            }
        }
        __syncthreads();
        {
            const bool right = w >= 4; const int cb = w & 3;
#define LDM(base, row, cblk) (*(const LAS bf16x4*)(lds + (base) + (row) * CRS + (cblk) * 32 + 8 * g))
#define LDF(base, tile) (*(const LAS bf16x4*)(lds + (base) + (tile) * 512 + lane * 8))
#define LDTI(row) (*(const LAS bf16x4*)(lds + L_MTI + (row) * 48 + 8 * g))
            bf16x4 XB[4];
#pragma unroll
            for (int i = 0; i < 4; ++i) {
                f32x4 Z;
                if (!right) Z = unpack4(LDF(L_AF, i * 4 + cb));
                else { Z = (f32x4){0.f, 0.f, 0.f, 0.f};
                    if (i == 0) Z = mfma32(cat8(LDM(L_MAK, m16, 0), zero4), cat8(LDF(L_VF, cb), zero4), Z);
                    if (i == 1) Z = mfma32(cat8(LDM(L_MAK, 16 + m16, 0), LDM(L_MAK, 16 + m16, 1)), cat8(LDF(L_VF, cb), LDF(L_VF, 4 + cb)), Z);
                    if (i == 2) { Z = mfma32(cat8(LDM(L_MAK, 32 + m16, 0), LDM(L_MAK, 32 + m16, 1)), cat8(LDF(L_VF, cb), LDF(L_VF, 4 + cb)), Z);
                                  Z = mfma32(cat8(LDM(L_MAK, 32 + m16, 2), zero4), cat8(LDF(L_VF, 8 + cb), zero4), Z); }
                    if (i == 3) { Z = mfma32(cat8(LDM(L_MAK, 48 + m16, 0), LDM(L_MAK, 48 + m16, 1)), cat8(LDF(L_VF, cb), LDF(L_VF, 4 + cb)), Z);
                                  Z = mfma32(cat8(LDM(L_MAK, 48 + m16, 2), LDM(L_MAK, 48 + m16, 3)), cat8(LDF(L_VF, 8 + cb), LDF(L_VF, 12 + cb)), Z); } }
                if (i == 1) Z = mfma32(cat8(LDM(L_MAB, 16 + m16, 0), zero4), cat8(XB[0], zero4), Z);
                if (i == 2) Z = mfma32(cat8(LDM(L_MAB, 32 + m16, 0), LDM(L_MAB, 32 + m16, 1)), cat8(XB[0], XB[1]), Z);
                if (i == 3) { Z = mfma32(cat8(LDM(L_MAB, 48 + m16, 0), LDM(L_MAB, 48 + m16, 1)), cat8(XB[0], XB[1]), Z);
                              Z = mfma32(cat8(LDM(L_MAB, 48 + m16, 2), zero4), cat8(XB[2], zero4), Z); }
                const f32x4 X = mfma32(cat8(LDTI(16 * i + m16), zero4), cat8(pack4(Z), zero4), (f32x4){0.f, 0.f, 0.f, 0.f});
                XB[i] = pack4(X);
            }
            unsigned char* fbase = ws + (size_t)((item & ~1023) | (h << 6) | ch) * 8192 + lane * 8;
            if (!right) {
                const LAS float* gl = (const LAS float*)(lds + L_GL);
#pragma unroll
                for (int kpb = 0; kpb < 4; ++kpb) {
                    f32x4 Dm = (f32x4){0.f, 0.f, 0.f, 0.f};
                    Dm = mfma32(cat8(XB[0], XB[1]), cat8(LDF(L_BHF, kpb), LDF(L_BHF, 4 + kpb)), Dm);
                    Dm = mfma32(cat8(XB[2], XB[3]), cat8(LDF(L_BHF, 8 + kpb), LDF(L_BHF, 12 + kpb)), Dm);
                    if (kpb == cb) { const float gv = gl[16 * cb + m16];
#pragma unroll
                        for (int jj = 0; jj < 4; ++jj) if (4 * g + jj == m16) Dm[jj] += gv; }
                    *(bf16x4*)(fbase + WS_MF + (kpb * 4 + cb) * 512) = pack4(Dm);
                }
#pragma unroll
                for (int i = 0; i < 4; ++i) {
                    f32x4 Dq = unpack4(*(const LAS bf16x4*)(lds + L_RT + (16 * i + m16) * CRS + cb * 32 + 8 * g));
                    if (i == 0) Dq = mfma32(cat8(XB[0], zero4), cat8(LDM(L_MRB, m16, 0), zero4), Dq);
                    if (i >= 1) Dq = mfma32(cat8(XB[0], XB[1]), cat8(LDM(L_MRB, 16 * i + m16, 0), LDM(L_MRB, 16 * i + m16, 1)), Dq);
                    if (i == 2) Dq = mfma32(cat8(XB[2], zero4), cat8(LDM(L_MRB, 32 + m16, 2), zero4), Dq);
                    if (i == 3) Dq = mfma32(cat8(XB[2], XB[3]), cat8(LDM(L_MRB, 48 + m16, 2), LDM(L_MRB, 48 + m16, 3)), Dq);
                    *(bf16x4*)(fbase + WS_QF + (i * 4 + cb) * 512) = pack4(Dq);
                }
            } else {
#pragma unroll
                for (int kpb = 0; kpb < 4; ++kpb) {
                    f32x4 Dn = (f32x4){0.f, 0.f, 0.f, 0.f};
                    Dn = mfma32(cat8(LDF(L_BHF, kpb), LDF(L_BHF, 4 + kpb)), cat8(XB[0], XB[1]), Dn);
                    Dn = mfma32(cat8(LDF(L_BHF, 8 + kpb), LDF(L_BHF, 12 + kpb)), cat8(XB[2], XB[3]), Dn);
                    Dn = mfma32(cat8(LDF(L_KHF, kpb), LDF(L_KHF, 4 + kpb)), cat8(LDF(L_VF, cb), LDF(L_VF, 4 + cb)), Dn);
                    Dn = mfma32(cat8(LDF(L_KHF, 8 + kpb), LDF(L_KHF, 12 + kpb)), cat8(LDF(L_VF, 8 + cb), LDF(L_VF, 12 + cb)), Dn);
                    *(bf16x4*)(fbase + WS_NF + (kpb * 4 + cb) * 512) = pack4(Dn);
                }
#pragma unroll
                for (int i = 0; i < 4; ++i) {
                    f32x4 Dy = (f32x4){0.f, 0.f, 0.f, 0.f};
                    if (i == 0) { Dy = mfma32(cat8(LDM(L_MRB, m16, 0), zero4), cat8(XB[0], zero4), Dy);
                                  Dy = mfma32(cat8(LDM(L_MRK, m16, 0), zero4), cat8(LDF(L_VF, cb), zero4), Dy); }
                    if (i >= 1) { Dy = mfma32(cat8(LDM(L_MRB, 16 * i + m16, 0), LDM(L_MRB, 16 * i + m16, 1)), cat8(XB[0], XB[1]), Dy);
                                  Dy = mfma32(cat8(LDM(L_MRK, 16 * i + m16, 0), LDM(L_MRK, 16 * i + m16, 1)), cat8(LDF(L_VF, cb), LDF(L_VF, 4 + cb)), Dy); }
                    if (i == 2) { Dy = mfma32(cat8(LDM(L_MRB, 32 + m16, 2), zero4), cat8(XB[2], zero4), Dy);
                                  Dy = mfma32(cat8(LDM(L_MRK, 32 + m16, 2), zero4), cat8(LDF(L_VF, 8 + cb), zero4), Dy); }
                    if (i == 3) { Dy = mfma32(cat8(LDM(L_MRB, 48 + m16, 2), LDM(L_MRB, 48 + m16, 3)), cat8(XB[2], XB[3]), Dy);
                                  Dy = mfma32(cat8(LDM(L_MRK, 48 + m16, 2), LDM(L_MRK, 48 + m16, 3)), cat8(LDF(L_VF, 8 + cb), LDF(L_VF, 12 + cb)), Dy); }
                    *(bf16x4*)(fbase + WS_Y0F + (i * 4 + cb) * 512) = pack4(Dy);
                }
            }
#undef LDM
#undef LDF
#undef LDTI
        }
#if PA_CONV
#pragma unroll
        for (int ee = 0; ee < 4; ++ee) { u32x4 o;
#pragma unroll
            for (int qd = 0; qd < 4; ++qd) o[qd] = pk4_fp8w(CA[4 * qd][ee] * FP8_MUL_W, CA[4 * qd + 1][ee] * FP8_MUL_W, CA[4 * qd + 2][ee] * FP8_MUL_W, CA[4 * qd + 3][ee] * FP8_MUL_W);
            *(u32x4*)(cd.dst + (size_t)ee * D) = o; }
#endif
        __syncthreads();
    }
#undef PA_ISSUE
}

__device__ __forceinline__ void ph_chunk_state(const Prm& p, const Ctx& c) {
    unsigned char* ws = p.ws; const int lane = c.lane;
    if (c.wave < 2) for (int wi = c.vb * 2 + c.wave; wi < 2 * NB * NH * 4; wi += c.nvb * 2) {
        const int seq = wi >> 2, vb = wi & 3;
        f32x4 ST[4];
#pragma unroll
        for (int kb = 0; kb < 4; ++kb) ST[kb] = (f32x4){0.f, 0.f, 0.f, 0.f};
        bf16x4 mf[3][16], nf[3][4];
#define PB_LOAD(buf, ch_) do { const int chc_ = (ch_) < 64 ? (ch_) : 63; const unsigned char* ib_ = ws + (size_t)(seq * 64 + chc_) * 8192 + lane * 8; \
            _Pragma("unroll") for (int q = 0; q < 16; ++q) mf[buf][q] = *(const bf16x4*)(ib_ + WS_MF + q * 512); \
            _Pragma("unroll") for (int q = 0; q < 4; ++q) nf[buf][q] = *(const bf16x4*)(ib_ + WS_NF + (q * 4 + vb) * 512); } while (0)
#define PB_STEP(buf, ch_) do { if ((ch_) < 64) { unsigned char* ob_ = ws + (size_t)(seq * 64 + (ch_)) * 8192 + lane * 8 + WS_SF; bf16x4 SB[4]; \
            _Pragma("unroll") for (int kb = 0; kb < 4; ++kb) { SB[kb] = pack4(ST[kb]); *(bf16x4*)(ob_ + (kb * 4 + vb) * 512) = SB[kb]; } \
            _Pragma("unroll") for (int kpb = 0; kpb < 4; ++kpb) { f32x4 Dn = unpack4(nf[buf][kpb]); \
                Dn = mfma32(cat8(mf[buf][kpb * 4 + 0], mf[buf][kpb * 4 + 1]), cat8(SB[0], SB[1]), Dn); \
                Dn = mfma32(cat8(mf[buf][kpb * 4 + 2], mf[buf][kpb * 4 + 3]), cat8(SB[2], SB[3]), Dn); ST[kpb] = Dn; } } } while (0)
        PB_LOAD(0, 0); PB_LOAD(1, 1);
#pragma unroll 1
        for (int ch = 0; ch < 64; ch += 3) {
            PB_LOAD(2, ch + 2); PB_STEP(0, ch);
            PB_LOAD(0, ch + 3); PB_STEP(1, ch + 1);
            PB_LOAD(1, ch + 4); PB_STEP(2, ch + 2);
        }
#undef PB_LOAD
#undef PB_STEP
    }
}

constexpr int YL_RS = 68;
__device__ __forceinline__ void ld8f(const float* p8, float* o) { const f32x4 t0 = *(const f32x4*)p8, t1 = *(const f32x4*)(p8 + 4); o[0] = t0.x; o[1] = t0.y; o[2] = t0.z; o[3] = t0.w; o[4] = t1.x; o[5] = t1.y; o[6] = t1.z; o[7] = t1.w; }
__device__ __forceinline__ void ph_chunk_out(const Prm& p, const Ctx& c) {
    unsigned char* ws = p.ws; const bf16_t* Pm = (const bf16_t*)(ws + WS_P); const float* mu = p.in[4]; const bf16_t* LOB = (const bf16_t*)(ws + WS_LOB); bf16_t* MIX = (bf16_t*)(ws + WS_MIX);
    LAS float* YL = (LAS float*)c.lds;
    const int lane = c.lane, m16 = lane & 15, g = lane >> 4, w = c.wave;
    const int d = w >> 2, i = w & 3;
    bf16x4 qf[4], y0f[4], sf[4][4];
#define PC_LOADFR(item_) do { const int h_ = (item_) & 15, n_ = ((item_) >> 4) & 63, b_ = (item_) >> 10; const int it_ = ((d * NB + b_) * NH + h_) * 64 + (d ? 63 - n_ : n_); \
        const unsigned char* ib_ = ws + (size_t)it_ * 8192 + lane * 8; \
        _Pragma("unroll") for (int kb = 0; kb < 4; ++kb) qf[kb] = *(const bf16x4*)(ib_ + WS_QF + (i * 4 + kb) * 512); \
        _Pragma("unroll") for (int vb = 0; vb < 4; ++vb) { y0f[vb] = *(const bf16x4*)(ib_ + WS_Y0F + (i * 4 + vb) * 512); \
            _Pragma("unroll") for (int kb = 0; kb < 4; ++kb) sf[kb][vb] = *(const bf16x4*)(ib_ + WS_SF + (kb * 4 + vb) * 512); } } while (0)
    if (c.vb < NB * NH * 64) PC_LOADFR(c.vb);
    for (int item = c.vb; item < NB * NH * 64; item += c.nvb) {
        const int h = item & 15, n = (item >> 4) & 63, b = item >> 10;
        const int rho = c.tid >> 3, cg = c.tid & 7, c8 = 8 * cg, tt = 64 * n + rho, tok = b * T + tt, col = h * HS + c8;
        const bool hp = tt > 0, hn = tt < T - 1;
        const u32x4 z4 = (u32x4){0u, 0u, 0u, 0u};
        bf16_t* mrow = MIX + (size_t)tok * D + col;
        float v[8], bon, lw8[8], lb8[8], g8[8];
        { const bf16_t* row = Pm + (size_t)tok * NINP + col;
          float a[8], pm[8], pn[8], mm[8];
          unpack8(*(const u32x4*)(row + 2 * RW), a); unpack8(hp ? *(const u32x4*)(row + 2 * RW - NINP) : z4, pm); unpack8(hn ? *(const u32x4*)(row + 2 * RW + NINP) : z4, pn); ld8f(mu + 2 * RW + col, mm);
#pragma unroll
          for (int q = 0; q < 8; ++q) v[q] = zshift(a[q], pm[q], pn[q], mm[q]);
          bon = ((const float*)(ws + WS_BON))[(size_t)tok * NH + h];
          ld8f(p.in[13] + col, lw8); ld8f(p.in[14] + col, lb8); unpack8(*(const u32x4*)(LOB + ((size_t)2 * M + tok) * RW + col), g8);
          const bf16_t* crow = Pm + (size_t)tok * NINP + NRC + col;
          float gb[8], gc[8], uu[8], cu0[8], cu1[8], cu2[8], o[8];
          unpack8(*(const u32x4*)crow, gb);
          unpack8(*(const u32x4*)(crow + CWD), gc); unpack8(*(const u32x4*)(crow + 2 * CWD), uu);
#pragma unroll
          for (int q = 0; q < 8; ++q) cu1[q] = gc[q] * uu[q];
          unpack8(hp ? *(const u32x4*)(crow + CWD - NINP) : z4, gc); unpack8(hp ? *(const u32x4*)(crow + 2 * CWD - NINP) : z4, uu);
#pragma unroll
          for (int q = 0; q < 8; ++q) cu0[q] = gc[q] * uu[q];
          unpack8(hn ? *(const u32x4*)(crow + CWD + NINP) : z4, gc); unpack8(hn ? *(const u32x4*)(crow + 2 * CWD + NINP) : z4, uu);
#pragma unroll
          for (int q = 0; q < 8; ++q) cu2[q] = gc[q] * uu[q];
          float w0[8], w1[8], w2[8]; ld8f(p.in[15] + col, w0); ld8f(p.in[15] + CWD + col, w1); ld8f(p.in[15] + 2 * CWD + col, w2);
#pragma unroll
          for (int q = 0; q < 8; ++q) o[q] = gb[q] * (w0[q] * cu0[q] + w1[q] * cu1[q] + w2[q] * cu2[q]);
          *(u32x4*)(mrow + RW) = (u32x4){pk2(o[0], o[1]), pk2(o[2], o[3]), pk2(o[4], o[5]), pk2(o[6], o[7])};
        }
#pragma unroll
        for (int vb = 0; vb < 4; ++vb) {
            f32x4 Dy = unpack4(y0f[vb]);
            Dy = mfma32(cat8(qf[0], qf[1]), cat8(sf[0][vb], sf[1][vb]), Dy);
            Dy = mfma32(cat8(qf[2], qf[3]), cat8(sf[2][vb], sf[3][vb]), Dy);
#pragma unroll
            for (int jj = 0; jj < 4; ++jj) { const int tau = 16 * i + 4 * g + jj, rr = d ? 63 - tau : tau; YL[(d * 64 + rr) * YL_RS + 16 * vb + m16] = Dy[jj]; }
        }
        if (item + c.nvb < NB * NH * 64) PC_LOADFR(item + c.nvb);
        __syncthreads();
        { float y[8];
          { const LAS float* y0 = YL + rho * YL_RS + c8; const LAS float* y1 = YL + (64 + rho) * YL_RS + c8;
#pragma unroll
            for (int q = 0; q < 8; ++q) y[q] = y0[q] + y1[q]; }
          float s1 = 0.f;
#pragma unroll
          for (int q = 0; q < 8; ++q) s1 += y[q];
          s1 += __shfl_xor(s1, 1); s1 += __shfl_xor(s1, 2); s1 += __shfl_xor(s1, 4);
          const float mean = s1 * (1.0f / 64.0f); float qv = 0.f;
#pragma unroll
          for (int q = 0; q < 8; ++q) { y[q] -= mean; qv += y[q] * y[q]; }
          qv += __shfl_xor(qv, 1); qv += __shfl_xor(qv, 2); qv += __shfl_xor(qv, 4);
          const float rstd = __builtin_amdgcn_rsqf(qv * (1.0f / 64.0f) + LNX_EPS);
          float o[8];
#pragma unroll
          for (int q = 0; q < 8; ++q) o[q] = (y[q] * rstd * lw8[q] + lb8[q] + bon * v[q]) * g8[q];
          *(u32x4*)mrow = (u32x4){pk2(o[0], o[1]), pk2(o[2], o[3]), pk2(o[4], o[5]), pk2(o[6], o[7])}; }
        __syncthreads();
    }
#undef PC_LOADFR
}

__device__ __forceinline__ void ph_gemm_out(const Prm& p, const Ctx& c) {
    unsigned char* ws = p.ws;
    ProbRes P{(const bf16_t*)(ws + WS_MIX), (const bf16_t*)(ws + WS_WOUT), p.in[0], (bf16_t*)(ws + WS_X1), D};
    pg8::Order S; S.init(M / 256, D / 256, c.nvb, c.vb, nullptr);
    { int m1, s_, c_; cv::slot_split(c.nvb, c.vb, m1, s_, c_); gemm_with_slot<ProbRes>(p, c, P, S, (M / 256) * (D / 256), (c.vb >> 3) % 3, m1 + c.nvb * NWAVES * CW3, CW7); }
}

constexpr int RT_GT = 8, RT_NG = M / RT_GT;
constexpr int RL_PART = 0, RL_SS = 65536, RL_LG = 67584, RL_RSTD = 75776;
__device__ __forceinline__ void ph_route(const Prm& p, const Ctx& c) {
    unsigned char* ws = p.ws; const bf16_t* X1 = (const bf16_t*)(ws + WS_X1); const bf16_t* RWT = (const bf16_t*)(ws + WS_RWT); const float* g = p.in[17]; const float* rb = p.in[19];
    bf16_t* H2 = (bf16_t*)(ws + WS_H2); int* SELE = (int*)(ws + WS_SELE); int* SELR = (int*)(ws + WS_SELR); float* SELG = (float*)(ws + WS_SELG); unsigned* HIST = (unsigned*)(ws + WS_HIST);
    LAS unsigned char* lds = c.lds;
    const int lane = c.lane, m16 = lane & 15, g4 = lane >> 4, w = c.wave;
    for (int blk = c.vb; blk < M / 64; blk += c.nvb) {
        const int tok0 = blk * 64, kw = 256 * w + 8 * g4;
        f32x4 acc[4][2]; float ssp[4] = {0.f, 0.f, 0.f, 0.f};
#pragma unroll
        for (int t = 0; t < 4; ++t) { acc[t][0] = (f32x4){0.f, 0.f, 0.f, 0.f}; acc[t][1] = (f32x4){0.f, 0.f, 0.f, 0.f}; }
#pragma unroll 1
        for (int sh = 0; sh < 4; ++sh) {
            bf16x8 xa[4][2];
#pragma unroll
            for (int t = 0; t < 4; ++t)
#pragma unroll
                for (int s4 = 0; s4 < 2; ++s4) xa[t][s4] = *(const bf16x8*)(X1 + (size_t)(tok0 + 16 * t + m16) * D + kw + 32 * (2 * sh + s4));
#pragma unroll
            for (int s4 = 0; s4 < 2; ++s4) {
                bf16x8 bw[2][3];
#pragma unroll
                for (int et = 0; et < 2; ++et)
#pragma unroll
                    for (int part = 0; part < 3; ++part) bw[et][part] = *(const bf16x8*)(RWT + (size_t)(part * NE + 16 * et + m16) * D + kw + 32 * (2 * sh + s4));
#pragma unroll
                for (int t = 0; t < 4; ++t) {
                    { const u32x4 xw = __builtin_bit_cast(u32x4, xa[t][s4]); float xv[8]; unpack8(xw, xv);
#pragma unroll
                      for (int q = 0; q < 8; ++q) ssp[t] += xv[q] * xv[q]; }
#pragma unroll
                    for (int et = 0; et < 2; ++et)
#pragma unroll
                        for (int part = 2; part >= 0; --part) acc[t][et] = mfma32(xa[t][s4], bw[et][part], acc[t][et]);
                }
            }
        }
#pragma unroll
        for (int t = 0; t < 4; ++t) { float v = ssp[t]; v += __shfl_xor(v, 16); v += __shfl_xor(v, 32); if (g4 == 0) ((LAS float*)(lds + RL_SS))[w * 64 + 16 * t + m16] = v;
            *(LAS f32x4*)(lds + RL_PART + ((w * 8 + t * 2 + 0) * 64 + lane) * 16) = acc[t][0]; *(LAS f32x4*)(lds + RL_PART + ((w * 8 + t * 2 + 1) * 64 + lane) * 16) = acc[t][1]; }
        __syncthreads();
        { const int tile = c.tid >> 6, ln = c.tid & 63; f32x4 v = (f32x4){0.f, 0.f, 0.f, 0.f};
#pragma unroll
          for (int ww = 0; ww < 8; ++ww) v += *(const LAS f32x4*)(lds + RL_PART + ((ww * 8 + tile) * 64 + ln) * 16);
          const int tk = 16 * (tile >> 1) + 4 * (ln >> 4), ex = 16 * (tile & 1) + (ln & 15);
#pragma unroll
          for (int r = 0; r < 4; ++r) ((LAS float*)(lds + RL_LG))[(tk + r) * NE + ex] = v[r];
          if (c.tid < 64) { float ss = 0.f;
#pragma unroll
              for (int ww = 0; ww < 8; ++ww) ss += ((const LAS float*)(lds + RL_SS))[ww * 64 + c.tid];
              ((LAS float*)(lds + RL_RSTD))[c.tid] = 1.0f / sqrtf(ss * (1.0f / D) + RMS_EPS); } }
        __syncthreads();
        unsigned mycnt = 0; const int grp = blk * 8 + w;
#pragma unroll 1
        for (int q = 0; q < 8; ++q) {
            const int tl = 8 * w + q, tok = tok0 + tl;
            const float rstd = ((const LAS float*)(lds + RL_RSTD))[tl];
            float lg[NE];
#pragma unroll
            for (int e4 = 0; e4 < NE / 4; ++e4) { const f32x4 v = *(const LAS f32x4*)(lds + RL_LG + (tl * NE + 4 * e4) * 4); const f32x4 bb = *(const f32x4*)(rb + 4 * e4);
                lg[4 * e4] = v.x * rstd + bb.x; lg[4 * e4 + 1] = v.y * rstd + bb.y; lg[4 * e4 + 2] = v.z * rstd + bb.z; lg[4 * e4 + 3] = v.w * rstd + bb.w; }
            { const u32x2* x4 = (const u32x2*)(X1 + (size_t)tok * D) + lane; unsigned* o4 = (unsigned*)((unsigned char*)H2 + (size_t)tok * D) + lane; const float rs = rstd * FP8_MUL_X;
#pragma unroll
              for (int j = 0; j < 8; ++j) { const u32x2 xw = x4[64 * j]; const f32x4 v = (f32x4){bf_lo(xw.x), bf_hi(xw.x), bf_lo(xw.y), bf_hi(xw.y)}, gg = ((const f32x4*)g)[lane + 64 * j];
                  o4[64 * j] = pk4_fp8(v.x * rs * gg.x, v.y * rs * gg.y, v.z * rs * gg.z, v.w * rs * gg.w); } }
            int se[4]; float sv[4];
#pragma unroll
            for (int kk = 0; kk < 4; ++kk) { float best = -3.0e38f; int bi = 0;
#pragma unroll
                for (int e = 0; e < NE; ++e) { const bool taken = (kk > 0 && se[0] == e) || (kk > 1 && se[1] == e) || (kk > 2 && se[2] == e); if (!taken && lg[e] > best) { best = lg[e]; bi = e; } }
                se[kk] = bi; sv[kk] = best; }
            const float e1 = __expf(sv[1] - sv[0]), e2 = __expf(sv[2] - sv[0]), e3 = __expf(sv[3] - sv[0]); const float inv = 1.0f / (1.0f + e1 + e2 + e3);
            const float gt[4] = {inv, e1 * inv, e2 * inv, e3 * inv};
#pragma unroll
            for (int kk = 0; kk < 4; ++kk) {
                const int ee = __builtin_amdgcn_readfirstlane(se[kk]);
                const unsigned rk = (unsigned)__builtin_amdgcn_readlane((int)mycnt, ee);
                if (lane == ee) ++mycnt;
                if (lane == kk) { SELE[tok * 4 + kk] = ee; SELR[tok * 4 + kk] = (int)rk; SELG[tok * 4 + kk] = gt[kk]; }
            }
        }
        if (lane < NE) HIST[(size_t)grp * NE + lane] = mycnt;
        __syncthreads();
    }
}

__device__ __forceinline__ void build_expert_table(const Prm& p, const Ctx& c) {
    LAS int* tab = (LAS int*)(c.lds + LDS_TAB); const unsigned* cnt = (const unsigned*)(p.ws + WS_CTL) + CW_CNT;
    if (c.tid < NE) tab[32 + c.tid] = (int)__hip_atomic_load(cnt + c.tid, __ATOMIC_RELAXED, __HIP_MEMORY_SCOPE_AGENT);
    __syncthreads();
    if (c.tid == 0) { int mt = 0;
        for (int e = 0; e < NE; ++e) { const int n = tab[32 + e], nt = (n + 255) >> 8; tab[e] = mt * 256;
            for (int j = 0; j < nt && mt + j < MAXMT; ++j) tab[128 + mt + j] = e; mt += nt; }
        tab[64] = mt < MAXMT ? mt : MAXMT; }
    __syncthreads();
}

__device__ __forceinline__ void ph_place(const Prm& p, const Ctx& c) {
    unsigned char* ws = p.ws;
    LAS int* tab = (LAS int*)(c.lds + LDS_TAB); LAS unsigned* red = (LAS unsigned*)c.lds;
    const unsigned* HIST = (const unsigned*)(ws + WS_HIST);
    const int gw0 = c.vb * NWAVES;
    { const int e = c.tid & 31, part = c.tid >> 5; unsigned tot = 0, pre = 0;
#pragma unroll 1
      for (int g0 = 0; g0 < RT_NG; g0 += 16 * 32) { unsigned hv[32];
#pragma unroll
          for (int i = 0; i < 32; ++i) hv[i] = HIST[(size_t)(g0 + part + 16 * i) * NE + e];
#pragma unroll
          for (int i = 0; i < 32; ++i) { tot += hv[i]; if (g0 + part + 16 * i < gw0) pre += hv[i]; } }
      red[part * 64 + e] = tot; red[part * 64 + 32 + e] = pre; }
    __syncthreads();
    if (c.tid < 64) { unsigned s = 0;
#pragma unroll
        for (int q = 0; q < 16; ++q) s += red[q * 64 + c.tid];
        tab[512 + c.tid] = (int)s; }
    __syncthreads();
    if (c.tid == 0) { int mt = 0;
        for (int e = 0; e < NE; ++e) { const int n = tab[512 + e], nt = (n + 255) >> 8; tab[e] = mt * 256; tab[32 + e] = n;
            for (int j = 0; j < nt && mt + j < MAXMT; ++j) tab[128 + mt + j] = e; mt += nt; }
        tab[64] = mt < MAXMT ? mt : MAXMT; }
    if (c.vb == 0 && c.tid < NE) __hip_atomic_store((unsigned*)(ws + WS_CTL) + CW_CNT + c.tid, (unsigned)tab[512 + c.tid], __ATOMIC_RELAXED, __HIP_MEMORY_SCOPE_AGENT);
    __syncthreads();
    int* ROWTOK = (int*)(ws + WS_XG); float* RG = (float*)(ws + WS_RGATE);
    const int* SELE = (const int*)(ws + WS_SELE); const int* SELR = (const int*)(ws + WS_SELR); const float* SELG = (const float*)(ws + WS_SELG); int* DEST = (int*)(ws + WS_DEST);
    const int gw = c.vb * NWAVES + c.wave, NGW = c.nvb * NWAVES;
    for (int grp = gw; grp < RT_NG; grp += NGW) {
        unsigned base = 0;
        if (c.lane < NE) { if (grp < gw0 + NWAVES) { unsigned hv[NWAVES - 1];
#pragma unroll
                               for (int q = 0; q < NWAVES - 1; ++q) hv[q] = HIST[(size_t)(gw0 + q) * NE + c.lane];
                               base = (unsigned)tab[544 + c.lane];
#pragma unroll
                               for (int q = 0; q < NWAVES - 1; ++q) if (gw0 + q < grp) base += hv[q]; }
                           else { for (int gq = 0; gq < grp; ++gq) base += HIST[(size_t)gq * NE + c.lane]; } }
        { const int a = grp * RT_GT * TOPK + (c.lane & 31), tok = a >> 2;
          const int e = SELE[a]; const unsigned be = (unsigned)__shfl((int)base, e);
          const int dest = tab[e] + (int)be + SELR[a];
          if (c.lane < RT_GT * TOPK) { ROWTOK[dest] = tok; RG[dest] = SELG[a]; DEST[a] = dest; } }
    }
    for (int it = gw; it < NE * 256; it += NGW) {
        const int e = it >> 8, j = it & 255, n = tab[32 + e], rem = n & 255;
        if (rem != 0 && j >= rem) { const int dest = tab[e] + (n & ~255) + j; if (c.lane == 0) { ROWTOK[dest] = 0; RG[dest] = 0.f; } }
    }
}

__device__ __forceinline__ void ph_gemm_gu(const Prm& p, const Ctx& c) {
    unsigned char* ws = p.ws; build_expert_table(p, c); const LAS int* tab = (const LAS int*)(c.lds + LDS_TAB);
    ProbGU P{(const bf16_t*)(ws + WS_H2), (const bf16_t*)(ws + WS_WGU), (bf16_t*)(ws + WS_ACT), p.in[21], D / 2};
    pg8::Order S; S.init(__builtin_amdgcn_readfirstlane(tab[64]), DFF / 128, c.nvb, c.vb, tab + 128);
    LAS unsigned* rowtab = (LAS unsigned*)(c.lds + LDS_ROWT); const int* ROWTOK = (const int*)(ws + WS_XG);
    { unsigned rv[ROWT_UNITS];
#pragma unroll
      for (int i = 0; i < ROWT_UNITS; ++i) { pg8::Unit u; const bool ok = S.next(i, u); rv[i] = (ok && c.tid < 256) ? (unsigned)ROWTOK[u.pm * 256 + c.tid] : 0u; }
#pragma unroll
      for (int i = 0; i < ROWT_UNITS; ++i) if (c.tid < 256) rowtab[i * 256 + c.tid] = rv[i] * (unsigned)D; }
    __syncthreads();
    pg8::gemm_phase<ProbGU, true, true, true>(c.lds, P, S, rowtab);
}
__device__ __forceinline__ void ph_gemm_dn(const Prm& p, const Ctx& c) {
    unsigned char* ws = p.ws; build_expert_table(p, c); const LAS int* tab = (const LAS int*)(c.lds + LDS_TAB);
    ProbDN P{(const bf16_t*)(ws + WS_ACT), (const bf16_t*)(ws + WS_WDN), (bf16_t*)(ws + WS_YB), p.in[23], (const float*)(ws + WS_RGATE), DFF / 2};
    pg8::Order S; S.init(__builtin_amdgcn_readfirstlane(tab[64]), D / 256, c.nvb, c.vb, tab + 128); pg8::gemm_phase<ProbDN, true, true>(c.lds, P, S);
}

__device__ __forceinline__ void ph_combine(const Prm& p, const Ctx& c) {
    unsigned char* ws = p.ws; const bf16_t* X1 = (const bf16_t*)(ws + WS_X1); const bf16_t* YB = (const bf16_t*)(ws + WS_YB); const int* DEST = (const int*)(ws + WS_DEST);
    bf16_t* X2 = (bf16_t*)(ws + WS_X2); bf16_t* HP = (bf16_t*)(ws + WS_HP); const float* g = p.in[24];
    const int gw = c.vb * NWAVES + c.wave, NGW = c.nvb * NWAVES;
    for (int tok0 = gw; tok0 < M; tok0 += 2 * NGW) {
        int tk[2]; tk[0] = tok0; tk[1] = tok0 + NGW < M ? tok0 + NGW : tok0; const bool two = tok0 + NGW < M;
        int dst[2][4];
#pragma unroll
        for (int t = 0; t < 2; ++t)
#pragma unroll
            for (int kk = 0; kk < 4; ++kk) dst[t][kk] = DEST[tk[t] * 4 + kk];
        u32x2 xw[2][8]; unsigned yw[2][4][8];
#pragma unroll
        for (int t = 0; t < 2; ++t) { const u32x2* xr = (const u32x2*)(X1 + (size_t)tk[t] * D) + c.lane;
#pragma unroll
            for (int j = 0; j < 8; ++j) xw[t][j] = xr[64 * j]; }
#pragma unroll
        for (int t = 0; t < 2; ++t)
#pragma unroll
            for (int kk = 0; kk < 4; ++kk) { const unsigned* yr = (const unsigned*)((const unsigned char*)YB + (size_t)dst[t][kk] * D) + c.lane;
#pragma unroll
                for (int j = 0; j < 8; ++j) yw[t][kk][j] = yr[64 * j]; }
#pragma unroll
        for (int t = 0; t < 2; ++t) { if (t == 1 && !two) break;
            const int tok = tk[t]; f32x4 v[8];
#pragma unroll
            for (int j = 0; j < 8; ++j) { v[j] = (f32x4){bf_lo(xw[t][j].x), bf_hi(xw[t][j].x), bf_lo(xw[t][j].y), bf_hi(xw[t][j].y)};
#pragma unroll
                for (int kk = 0; kk < 4; ++kk) { const unsigned w = yw[t][kk][j]; const f32x2 lo = __builtin_amdgcn_cvt_pk_f32_fp8(w, false), hi = __builtin_amdgcn_cvt_pk_f32_fp8(w, true);
                    v[j].x += lo.x * (1.0f / YB_MUL); v[j].y += lo.y * (1.0f / YB_MUL); v[j].z += hi.x * (1.0f / YB_MUL); v[j].w += hi.y * (1.0f / YB_MUL); } }
            float s = 0.f; u32x2* xo = (u32x2*)(X2 + (size_t)tok * D) + c.lane;
#pragma unroll
            for (int j = 0; j < 8; ++j) { xo[64 * j] = (u32x2){pk2(v[j].x, v[j].y), pk2(v[j].z, v[j].w)}; s += (v[j].x * v[j].x + v[j].y * v[j].y) + (v[j].z * v[j].z + v[j].w * v[j].w); }
            const float rstd = 1.0f / sqrtf(wave_sum(s) * (1.0f / D) + RMS_EPS);
            unsigned* o4 = (unsigned*)((unsigned char*)HP + (size_t)tok * D) + c.lane; const float rs = rstd * FP8_MUL_X;
#pragma unroll
            for (int j = 0; j < 8; ++j) { const f32x4 gg = ((const f32x4*)g)[c.lane + 64 * j];
                o4[64 * j] = pk4_fp8(v[j].x * rs * gg.x, v[j].y * rs * gg.y, v[j].z * rs * gg.z, v[j].w * rs * gg.w); }
        }
    }
}

__device__ __forceinline__ void ph_gemm_ple(const Prm& p, const Ctx& c) {
    unsigned char* ws = p.ws;
    ProbPLE P{(const bf16_t*)(ws + WS_HP), (const bf16_t*)(ws + WS_WPG), (const bf16_t*)(ws + WS_X2), (const bf16_t*)(ws + WS_PP), (bf16_t*)(ws + WS_X3), D / 2};
    pg8::Order S; S.init(M / 256, D / 256, c.nvb, c.vb, nullptr); pg8::gemm_phase<ProbPLE, true, true>(c.lds, P, S);
}

__device__ __forceinline__ void ph_final(const Prm& p, const Ctx& c) {
    const float* g = p.in[27];
    const int gw = c.vb * NWAVES + c.wave, NGW = c.nvb * NWAVES;
    for (int tok0 = gw; tok0 < M; tok0 += 2 * NGW) {
        const bool two = tok0 + NGW < M; int tk[2]; tk[0] = tok0; tk[1] = two ? tok0 + NGW : tok0;
        u32x2 xw[2][8];
#pragma unroll
        for (int t = 0; t < 2; ++t) { const u32x2* xi = (const u32x2*)((const bf16_t*)(p.ws + WS_X3) + (size_t)tk[t] * D) + c.lane;
#pragma unroll
            for (int j = 0; j < 8; ++j) xw[t][j] = xi[64 * j]; }
#pragma unroll
        for (int t = 0; t < 2; ++t) { if (t == 1 && !two) break;
            f32x4* xr = (f32x4*)(p.out + (size_t)tk[t] * D) + c.lane; f32x4 v[8]; float s = 0.f;
#pragma unroll
            for (int j = 0; j < 8; ++j) { v[j] = (f32x4){bf_lo(xw[t][j].x), bf_hi(xw[t][j].x), bf_lo(xw[t][j].y), bf_hi(xw[t][j].y)}; s += (v[j].x * v[j].x + v[j].y * v[j].y) + (v[j].z * v[j].z + v[j].w * v[j].w); }
            const float rstd = 1.0f / sqrtf(wave_sum(s) * (1.0f / D) + RMS_EPS);
#pragma unroll
            for (int j = 0; j < 8; ++j) { const f32x4 gg = ((const f32x4*)g)[c.lane + 64 * j]; xr[64 * j] = (f32x4){v[j].x * rstd * gg.x, v[j].y * rstd * gg.y, v[j].z * rstd * gg.z, v[j].w * rstd * gg.w}; }
        }
    }
}

constexpr int NPHASE = 15;
template <int PH> __device__ __forceinline__ void run_phase(const Prm& p, const Ctx& c) {
    if constexpr (PH == 0) ph_prologue(p, c);
    else if constexpr (PH == 1) ph_gemm_in(p, c);
    else if constexpr (PH == 2) ph_lora_in(p, c);
    else if constexpr (PH == 3) ph_gemm_lora(p, c);
    else if constexpr (PH == 4) ph_chunk_pre(p, c);
    else if constexpr (PH == 5) ph_chunk_state(p, c);
    else if constexpr (PH == 6) ph_chunk_out(p, c);
    else if constexpr (PH == 7) ph_gemm_out(p, c);
    else if constexpr (PH == 8) ph_route(p, c);
    else if constexpr (PH == 9) ph_place(p, c);
    else if constexpr (PH == 10) ph_gemm_gu(p, c);
    else if constexpr (PH == 11) ph_gemm_dn(p, c);
    else if constexpr (PH == 12) ph_combine(p, c);
    else if constexpr (PH == 13) ph_gemm_ple(p, c);
    else ph_final(p, c);
}
__device__ __forceinline__ Ctx make_ctx(unsigned char* lds) {
    Ctx c; c.lds = (LAS unsigned char*)lds; c.tid = threadIdx.x; asm volatile("" : "+v"(c.tid)); c.lane = c.tid & 63; c.wave = __builtin_amdgcn_readfirstlane(c.tid >> 6); c.vb = blockIdx.x; c.nvb = gridDim.x; return c;
}

template <int PH> __global__ void __launch_bounds__(NTHR, 2) k_phase(Prm p) {
    extern __shared__ __attribute__((aligned(16))) unsigned char lds[];
    const Ctx c = make_ctx(lds);
    run_phase<PH>(p, c);
}

__global__ void __launch_bounds__(NTHR, 2) k_all(Prm p) {
    extern __shared__ __attribute__((aligned(16))) unsigned char lds[];
    const Ctx c = make_ctx(lds);
    if (c.tid < 4) ((LAS unsigned*)(c.lds + LDS_BARW))[c.tid] = 0u;
    __syncthreads();
    XcdBarrier bar = xcd_barrier_post((unsigned*)(p.ws + WS_CTL) + CW_BAR, (volatile LAS unsigned*)(c.lds + LDS_BARW));
#define RUN_PH(k) do { const Ctx c = make_ctx(lds); run_phase<k>(p, c); if ((REP_MASK >> (k)) & 1) { xcd_barrier(bar); \
        run_phase<k>(p, c); } } while (0)
    RUN_PH(0); xcd_barrier(bar);
    RUN_PH(1); xcd_barrier(bar);
    RUN_PH(2); xcd_barrier(bar);
    RUN_PH(3); xcd_barrier(bar);
    RUN_PH(4); xcd_barrier(bar);
    RUN_PH(5); xcd_barrier(bar);
    RUN_PH(6); xcd_barrier(bar);
    RUN_PH(7); xcd_barrier(bar);
    RUN_PH(8); xcd_barrier(bar);
    RUN_PH(9); xcd_barrier(bar);
    RUN_PH(10); xcd_barrier(bar);
    RUN_PH(11); xcd_barrier(bar);
    RUN_PH(12); xcd_barrier(bar);
    RUN_PH(13); xcd_barrier(bar);
    RUN_PH(14);
}

template <int PH> static void launch_phase(const Prm& prm, int grid, hipStream_t stream) {
    static bool attr = false;
    if (!attr) { (void)hipFuncSetAttribute((const void*)k_phase<PH>, hipFuncAttributeMaxDynamicSharedMemorySize, LDS_BYTES); attr = true; }
    hipLaunchKernelGGL(k_phase<PH>, dim3(grid), dim3(NTHR), LDS_BYTES, stream, prm);
}

extern "C" void kernel_launch(void* const* d_in, const int* in_sizes, int n_in, void* d_out, int out_size, void* d_ws, size_t ws_size, hipStream_t stream) {
    static int grid = 0;
    if (grid == 0) {
        if (n_in != 28 || out_size != M * D || ws_size < WS_END) { fprintf(stderr, "kernel_launch: unexpected shapes (n_in %d out %d ws %zu need %zu)\n", n_in, out_size, ws_size, (size_t)WS_END); grid = -1; return; }
        int dev = 0, cus = 0;
        if (hipGetDevice(&dev) != hipSuccess || hipDeviceGetAttribute(&cus, hipDeviceAttributeMultiprocessorCount, dev) != hipSuccess || cus < 1) { grid = -1; return; }
        (void)hipFuncSetAttribute((const void*)k_all, hipFuncAttributeMaxDynamicSharedMemorySize, LDS_BYTES);
        int per_cu = 0; (void)hipOccupancyMaxActiveBlocksPerMultiprocessor(&per_cu, (const void*)k_all, NTHR, LDS_BYTES); (void)hipGetLastError();
        grid = cus;
    }
    if (grid < 0) return;
    (void)hipMemsetAsync((char*)d_ws + WS_CTL, 0, CTL_BYTES, stream);
    Prm prm{};
    for (int i = 0; i < 28; ++i) prm.in[i] = (const float*)d_in[i];
    prm.out = (float*)d_out; prm.ws = (unsigned char*)d_ws;
#if N_LAUNCH_MODE == 1
    hipLaunchKernelGGL(k_all, dim3(grid), dim3(NTHR), LDS_BYTES, stream, prm);
#else
    launch_phase<0>(prm, grid, stream); launch_phase<1>(prm, grid, stream); launch_phase<2>(prm, grid, stream); launch_phase<3>(prm, grid, stream);
    launch_phase<4>(prm, grid, stream); launch_phase<5>(prm, grid, stream); launch_phase<6>(prm, grid, stream); launch_phase<7>(prm, grid, stream);
    launch_phase<8>(prm, grid, stream); launch_phase<9>(prm, grid, stream); launch_phase<10>(prm, grid, stream); launch_phase<11>(prm, grid, stream);
    launch_phase<12>(prm, grid, stream); launch_phase<13>(prm, grid, stream); launch_phase<14>(prm, grid, stream);
#endif
}
```

```cpp
#include <hip/hip_runtime.h>
#include <cstdio>
#include <cstdint>

#ifndef N_LAUNCH_MODE
#define N_LAUNCH_MODE 1
#endif

#ifndef REP_MASK
#define REP_MASK 0x0
#endif
#define LAS __attribute__((address_space(3)))
#define GAS __attribute__((address_space(1)))
typedef unsigned short bf16_t;
typedef short bf16x8 __attribute__((ext_vector_type(8)));
typedef float f32x4 __attribute__((ext_vector_type(4)));
typedef float f32x2 __attribute__((ext_vector_type(2)));
typedef unsigned u32x4 __attribute__((ext_vector_type(4)));
typedef unsigned u32x2 __attribute__((ext_vector_type(2)));
typedef int i32x8 __attribute__((ext_vector_type(8)));
typedef int i32x4 __attribute__((ext_vector_type(4)));
constexpr int FP8_SCALE_W = 0x77777777, FP8_SCALE_X = 0x7D7D7D7D;
constexpr float FP8_MUL_W = 256.0f, FP8_MUL_X = 4.0f, YB_MUL = 16.0f;

constexpr int D = 2048, NB = 4, T = 4096, M = NB * T, PLE = 256, RW = 1024, CWD = 1024, HS = 64, NH = 16;
constexpr int DL = 64, IL = 64, GL = 160, NE = 32, TOPK = 4, DFF = 2048;
constexpr int NRC = 3 * RW + 2 * DL + 2 * IL + GL;
constexpr int NIN = NRC + 3 * CWD;
constexpr int NINP = 6656;
constexpr int LK = 512, LNN = 5 * RW;
constexpr int MAXROWS = M * TOPK + NE * 256;
constexpr int MAXMT = MAXROWS / 256;
constexpr float RMS_EPS = 1e-5f, LNX_EPS = 64e-5f;
constexpr int NTHR = 512, NWAVES = 8;

constexpr size_t MiB = 1ull << 20;
constexpr size_t WS_CTL = 0, CTL_BYTES = 1 * MiB;
constexpr size_t WS_RWT = WS_CTL + 512 * 1024;
constexpr size_t WS_WIN = WS_CTL + CTL_BYTES;
constexpr size_t WS_WLORA = WS_WIN + (size_t)NINP * D * 2;
constexpr size_t WS_WOUT = WS_WLORA + (size_t)LNN * LK * 2;
constexpr size_t WS_WGU = WS_WOUT + (size_t)D * D * 2;
constexpr size_t WS_WDN = WS_WGU + (size_t)NE * 2 * DFF * D;
constexpr size_t WS_WPG = WS_WDN + (size_t)NE * D * DFF;
constexpr size_t WS_WPP = WS_WPG + (size_t)D * D * 2;
constexpr size_t WS_RWG = WS_WPP + (size_t)D * PLE * 2;
constexpr size_t WS_H = WS_RWG + (size_t)D * NE * 4;
constexpr size_t WS_PBF = WS_H + (size_t)M * D * 2;
constexpr size_t WS_P = WS_PBF + (size_t)M * PLE * 2;
constexpr size_t WS_PP = WS_P + (size_t)M * NINP * 2;
constexpr size_t WS_LA = WS_PP + (size_t)M * D * 2;
constexpr size_t WS_LOUT = WS_LA + (size_t)M * LK * 2;
constexpr size_t FRAG_BYTES = (size_t)2 * NB * NH * 64 * 16 * 512;
constexpr size_t WS_LOB = WS_LOUT + (size_t)2 * M * RW * 4;
constexpr size_t WS_BON = WS_LOUT + (size_t)M * RW * 4;
constexpr size_t WS_MF = WS_LOUT + (size_t)5 * M * RW * 4;
constexpr size_t WS_NF = WS_MF + FRAG_BYTES;
constexpr size_t WS_QF = WS_NF + FRAG_BYTES;
constexpr size_t WS_Y0F = WS_QF + FRAG_BYTES;
constexpr size_t WS_SF = WS_Y0F + FRAG_BYTES;
constexpr size_t WS_MIX = WS_SF + FRAG_BYTES;
constexpr size_t WS_X1 = WS_MIX + (size_t)M * D * 2;
constexpr size_t WS_X3 = WS_X1 + (size_t)M * D * 2;
constexpr size_t WS_H2 = WS_X1 + (size_t)M * D * 4;
constexpr size_t WS_SELE = WS_H2 + (size_t)M * D;
constexpr size_t WS_SELR = WS_SELE + (size_t)M * 4 * 4;
constexpr size_t WS_SELG = WS_SELR + (size_t)M * 4 * 4;
constexpr size_t WS_DEST = WS_SELG + (size_t)M * 4 * 4;
constexpr size_t WS_HIST = WS_DEST + (size_t)M * 4 * 4;
constexpr size_t WS_RGATE = WS_HIST + (size_t)(M / 8) * NE * 4;
constexpr size_t WS_XG = WS_RGATE + (size_t)MAXROWS * 4;
constexpr size_t WS_ACT = WS_XG + (size_t)MAXROWS * 4;
constexpr size_t WS_YB = WS_ACT + (size_t)MAXROWS * DFF;
constexpr size_t WS_X2 = WS_YB + (size_t)MAXROWS * D * 2;
constexpr size_t WS_HP = WS_X2 + (size_t)M * D * 4;
constexpr size_t WS_END = WS_HP + (size_t)M * D * 2;
static_assert(WS_END <= 4096ull * MiB, "workspace map must fit 4 GiB");
static_assert(WS_WIN % 256 == 0 && WS_RWG % 256 == 0 && WS_XG % 256 == 0 && WS_RGATE % 256 == 0, "alignment");

constexpr int CW_BAR = 0;
constexpr int CW_CNT = 4096;

constexpr int LDS_STAGE = 131072;
constexpr int LDS_BARW = LDS_STAGE;
constexpr int LDS_TAB = LDS_STAGE + 64;
constexpr int LDS_ROWT = LDS_STAGE + 4096;
constexpr int ROWT_UNITS = 18;
constexpr int LDS_BYTES = LDS_ROWT + ROWT_UNITS * 1024;

struct Prm { const float* in[28]; float* out; unsigned char* ws; };

__device__ __forceinline__ unsigned f2bf(float f) { unsigned u = __float_as_uint(f); return (u + 0x7fffu + ((u >> 16) & 1u)) >> 16; }
typedef __bf16 bfv2_t __attribute__((ext_vector_type(2)));
typedef _Float16 hv2_t __attribute__((ext_vector_type(2)));
__device__ __forceinline__ unsigned pkh2(float lo, float hi) { const f32x2 v = (f32x2){lo, hi}; const hv2_t h = __builtin_convertvector(v, hv2_t); return __builtin_bit_cast(unsigned, h); }
__device__ __forceinline__ f32x2 unpkh2(unsigned w) { return __builtin_convertvector(__builtin_bit_cast(hv2_t, w), f32x2); }
__device__ __forceinline__ unsigned pk2(float lo, float hi) { const f32x2 v = (f32x2){lo, hi}; const bfv2_t b = __builtin_convertvector(v, bfv2_t); return __builtin_bit_cast(unsigned, b); }
__device__ __forceinline__ float bf_lo(unsigned w) { return __uint_as_float(w << 16); }
__device__ __forceinline__ float bf_hi(unsigned w) { return __uint_as_float(w & 0xffff0000u); }
__device__ __forceinline__ unsigned cvt_pk_bf16(float lo, float hi) { unsigned r; asm volatile("v_cvt_pk_bf16_f32 %0, %1, %2" : "=v"(r) : "v"(lo), "v"(hi)); return r; }
__device__ __forceinline__ unsigned pk4_fp8(float a, float b, float c, float d) {
    a = fminf(fmaxf(a, -448.f), 448.f); b = fminf(fmaxf(b, -448.f), 448.f); c = fminf(fmaxf(c, -448.f), 448.f); d = fminf(fmaxf(d, -448.f), 448.f);
    unsigned r = 0u; r = __builtin_amdgcn_cvt_pk_fp8_f32(a, b, r, false); r = __builtin_amdgcn_cvt_pk_fp8_f32(c, d, r, true); return r; }
__device__ __forceinline__ unsigned pk4_fp8w(float a, float b, float c, float d) {
    unsigned r = 0u; r = __builtin_amdgcn_cvt_pk_fp8_f32(a, b, r, false); r = __builtin_amdgcn_cvt_pk_fp8_f32(c, d, r, true); return r; }
__device__ __forceinline__ float wave_sum(float v) {
#pragma unroll
    for (int o = 1; o < 64; o <<= 1) v += __shfl_xor(v, o);
    return v;
}
__device__ __forceinline__ float sigmoidf_(float x) { return __builtin_amdgcn_rcpf(1.0f + __expf(-x)); }
#define LDS_WAIT() asm volatile("s_waitcnt lgkmcnt(0)" ::: "memory")
#define VM_WAIT() asm volatile("s_waitcnt vmcnt(0)" ::: "memory")
__device__ __forceinline__ void unpack8(const u32x4 w, float* o) { o[0] = bf_lo(w.x); o[1] = bf_hi(w.x); o[2] = bf_lo(w.y); o[3] = bf_hi(w.y); o[4] = bf_lo(w.z); o[5] = bf_hi(w.z); o[6] = bf_lo(w.w); o[7] = bf_hi(w.w); }
__device__ __forceinline__ void load16bf(const bf16_t* p, bool valid, float* o) {
    u32x4 a = (u32x4){0u, 0u, 0u, 0u}, b = a;
    if (valid) { a = *(const u32x4*)p; b = *(const u32x4*)(p + 8); }
    unpack8(a, o); unpack8(b, o + 8);
}
__device__ __forceinline__ void load16f(const float* p, float* o) {
#pragma unroll
    for (int i = 0; i < 4; ++i) { const f32x4 v = *(const f32x4*)(p + 4 * i); o[4 * i] = v.x; o[4 * i + 1] = v.y; o[4 * i + 2] = v.z; o[4 * i + 3] = v.w; }
}
__device__ __forceinline__ void store16f(float* p, const float* o) {
#pragma unroll
    for (int i = 0; i < 4; ++i) *(f32x4*)(p + 4 * i) = (f32x4){o[4 * i], o[4 * i + 1], o[4 * i + 2], o[4 * i + 3]};
}

namespace pg8 {
constexpr int BM = 256, BK = 64, HALF = 128, HTB = HALF * BK * 2, STAGE_BYTES = 8 * HTB, NXCD = 8, WGM = 8;
__host__ __device__ __forceinline__ int lds_byte(int r, int c) { const int st = (r >> 4) * 2 + (c >> 5), rr = r & 15, cc = c & 31, ob = rr * 64 + cc * 2; return st * 1024 + (ob ^ (((ob >> 9) & 1) << 5)); }
__host__ __device__ __forceinline__ void stage_rc(int b, int& R, int& C) { const int st = b / 1024, sb = b % 1024, swz = sb ^ (((sb >> 9) & 1) << 5); R = (st >> 1) * 16 + swz / 64; C = (st & 1) * 32 + (swz % 64) / 2; }
__host__ __device__ __forceinline__ int perm32(int rho) { const int n = rho >> 4, i = rho & 15; return 8 * (i >> 2) + 4 * n + (i & 3); }
__host__ __device__ __forceinline__ int perm128(int R) { return 64 * (R >> 5) + 16 * ((R >> 2) & 3) + 4 * ((R >> 4) & 1) + (R & 3); }

struct Unit { int pm, pn, e; };

struct Order {
    int nM, nN, nwg, G, c, lo, hi; const LAS int* blk_e;
    __device__ void init(int nM_, int nN_, int G_, int c_, const LAS int* be) { nM = nM_; nN = nN_; nwg = nM * nN; G = G_; c = c_; blk_e = be; lo = 0; hi = 0x7fffffff; }
    __device__ bool next(int i, Unit& u) const {
        if (i + lo >= hi) return false;
        const long L = (long)(i + lo) * G + c; if (L >= nwg) return false;
        int wgid = (int)L; { const int q = nwg / NXCD, r = nwg % NXCD, xcd = wgid % NXCD, off = wgid / NXCD; wgid = (xcd < r ? xcd * (q + 1) : r * (q + 1) + (xcd - r) * q) + off; }
        const int nig = WGM * nN, gid = wgid / nig, fm = gid * WGM, gsz = (nM - fm) < WGM ? (nM - fm) : WGM;
        u.pm = fm + ((wgid % nig) % gsz); u.pn = (wgid % nig) / gsz;
        u.e = blk_e ? __builtin_amdgcn_readfirstlane(blk_e[u.pm]) : 0;
        return true;
    }
};

template <class Prob, bool ALIGN_EPI, bool FP8 = false, bool GATHER = false>
__device__ __forceinline__ void gemm_phase(LAS unsigned char* lds, const Prob& P, const Order& S, const LAS unsigned* rowtab = nullptr) {
    int tid_ = threadIdx.x; asm volatile("" : "+v"(tid_));
    const int tid = tid_, wid = __builtin_amdgcn_readfirstlane(tid >> 6), lane = tid & 63, wr = wid >> 2, wc = wid & 3, fr = lane & 15, fq = lane >> 4;
    const int K = P.K, nt = P.kloop() / BK;
    unsigned voffA[2], voffB[2]; int gR[2]; unsigned gC[2]; unsigned vgc[2][2], vgn[2][2];
#pragma unroll
    for (int i = 0; i < 2; ++i) { int R, C; stage_rc(tid * 16 + i * 8192, R, C); const int Rb = ((int)Prob::PERM == 2) ? perm128(R) : (Prob::PERM ? ((R & ~31) + perm32(R & 31)) : R);
        voffA[i] = (unsigned)(R * K + C) * 2u; voffB[i] = (unsigned)(Rb * K + C) * 2u; gR[i] = R; gC[i] = (unsigned)C * 2u; }
#define PG8_GLOAD(dst, uidx) do { if constexpr (GATHER) { _Pragma("unroll") for (int h_ = 0; h_ < 2; ++h_) _Pragma("unroll") for (int i_ = 0; i_ < 2; ++i_) dst[h_][i_] = rowtab[(uidx) * 256 + h_ * 128 + gR[i_]] + gC[i_]; } } while (0)
    const size_t kstep = (size_t)(BK * 2);
    const size_t hstep = (size_t)HALF * K * 2;
    const size_t hstepB = ((int)Prob::PERM == 2) ? (size_t)8 * K * 2 : hstep;
    const unsigned ldsw = (unsigned)wid * 1024u;
    const int aoff = lds_byte(wr * 64 + fr, fq * 8), boff = lds_byte(wc * 32 + fr, fq * 8);
#define PG8_SA(b, h) (((b) * 2 + (h)) * HTB)
#define PG8_SB(b, h) ((4 + (b) * 2 + (h)) * HTB)
#define PG8_STAGE(bufoff, gbase, voff) do { _Pragma("unroll") for (int _i = 0; _i < 2; ++_i) \
        __builtin_amdgcn_global_load_lds((const unsigned*)((const char*)(gbase) + (voff)[_i]), (LAS unsigned*)(lds + (bufoff) + ldsw + _i * 8192), 16, 0, 0); } while (0)
#define PG8_STAGE_A(bufoff, kbase, H, nx) do { _Pragma("unroll") for (int _i = 0; _i < 2; ++_i) { \
        const unsigned vo_ = GATHER ? ((nx) ? vgn[H][_i] : vgc[H][_i]) : voffA[_i]; \
        __builtin_amdgcn_global_load_lds((const unsigned*)((const char*)(kbase) + (GATHER ? (size_t)0 : hstep * (H)) + vo_), (LAS unsigned*)(lds + (bufoff) + ldsw + _i * 8192), 16, 0, 0); } } while (0)
#define PG8_LDA(dst, b, h) do { _Pragma("unroll") for (int m = 0; m < 4; ++m) { const i32x4 lo_ = *(const LAS i32x4*)(lds + PG8_SA(b, h) + aoff + m * 2048), hi_ = *(const LAS i32x4*)(lds + PG8_SA(b, h) + aoff + m * 2048 + 1024); dst[m] = __builtin_shufflevector(lo_, hi_, 0, 1, 2, 3, 4, 5, 6, 7); } } while (0)
#define PG8_LDB(dst, b, h) do { _Pragma("unroll") for (int n = 0; n < 2; ++n) { const i32x4 lo_ = *(const LAS i32x4*)(lds + PG8_SB(b, h) + boff + n * 2048), hi_ = *(const LAS i32x4*)(lds + PG8_SB(b, h) + boff + n * 2048 + 1024); dst[n] = __builtin_shufflevector(lo_, hi_, 0, 1, 2, 3, 4, 5, 6, 7); } } while (0)
#define PG8_H0(v) __builtin_bit_cast(bf16x8, __builtin_shufflevector(v, v, 0, 1, 2, 3))
#define PG8_H1(v) __builtin_bit_cast(bf16x8, __builtin_shufflevector(v, v, 4, 5, 6, 7))
#define PG8_MMA(ai, bj, At, Bt) do { __builtin_amdgcn_s_setprio(1); _Pragma("unroll") for (int m = 0; m < 4; ++m) _Pragma("unroll") for (int n = 0; n < 2; ++n) { \
        acc[ai][bj][m][n] = __builtin_amdgcn_mfma_f32_16x16x32_bf16(PG8_H0(Bt[n]), PG8_H0(At[m]), acc[ai][bj][m][n], 0, 0, 0); \
        acc[ai][bj][m][n] = __builtin_amdgcn_mfma_f32_16x16x32_bf16(PG8_H1(Bt[n]), PG8_H1(At[m]), acc[ai][bj][m][n], 0, 0, 0); } __builtin_amdgcn_s_setprio(0); } while (0)
#define PG8_MMA8(ai, bj, At, Bt) do { __builtin_amdgcn_s_setprio(1); _Pragma("unroll") for (int m = 0; m < 4; ++m) _Pragma("unroll") for (int n = 0; n < 2; ++n) \
        asm volatile("v_mfma_scale_f32_16x16x128_f8f6f4 %0, %1, %2, %0, %3, %4 op_sel_hi:[0,0,0]" : "+v"(acc[ai][bj][m][n]) : "v"(Bt[n]), "v"(At[m]), "v"(fp8_sw), "v"(fp8_sx)); __builtin_amdgcn_s_setprio(0); } while (0)
#define PG8_MM(ai, bj, At, Bt) do { if constexpr (FP8) PG8_MMA8(ai, bj, At, Bt); else PG8_MMA(ai, bj, At, Bt); } while (0)
#define PG8_WAIT_V(n) asm volatile("s_waitcnt vmcnt(" #n ")" ::: "memory")
#define PG8_WAIT_L(n) asm volatile("s_waitcnt lgkmcnt(" #n ")" ::: "memory")
#define PG8_BAR __builtin_amdgcn_s_barrier()
#define PG8_SCHED __builtin_amdgcn_sched_barrier(0)
    Unit cur, nxt; int ui = 0;
    if (!S.next(0, cur)) return;
    f32x4 acc[2][2][4][2];
#pragma unroll
    for (int a = 0; a < 2; ++a)
#pragma unroll
        for (int b = 0; b < 2; ++b)
#pragma unroll
            for (int m = 0; m < 4; ++m)
#pragma unroll
                for (int n = 0; n < 2; ++n) acc[a][b][m][n] = (f32x4){0.f, 0.f, 0.f, 0.f};
    i32x8 At[4], B0[2], B1[2]; const int fp8_sw = FP8_SCALE_W, fp8_sx = FP8_SCALE_X; (void)fp8_sw; (void)fp8_sx;
    const char* cA = P.Aptr(cur); const char* cB = P.Bptr(cur);
    PG8_GLOAD(vgc, 0); PG8_GLOAD(vgn, 0);
    PG8_STAGE(PG8_SB(0, 0), cB, voffB); PG8_STAGE(PG8_SB(0, 1), cB + hstepB, voffB); PG8_STAGE_A(PG8_SA(0, 0), cA, 0, false); PG8_STAGE_A(PG8_SA(0, 1), cA, 1, false);
    if (wr == 1) PG8_BAR;
    PG8_WAIT_V(2); PG8_BAR;
    PG8_STAGE(PG8_SB(1, 0), cB + kstep, voffB); PG8_STAGE_A(PG8_SA(1, 0), cA + kstep, 0, false); PG8_STAGE(PG8_SB(1, 1), cB + hstepB + kstep, voffB);
    PG8_WAIT_V(6); PG8_BAR;
    for (;;) {
        const bool has_next = S.next(ui + 1, nxt);
        if (has_next) PG8_GLOAD(vgn, ui + 1);
        const char* nA = has_next ? P.Aptr(nxt) : cA; const char* nB = has_next ? P.Bptr(nxt) : cB;
        for (int t = 0; t < nt; t += 2) {
            const bool last = (t == nt - 2);
            const char* a1 = cA + (size_t)(t + 1) * kstep;
            const char* a2 = last ? nA : cA + (size_t)(t + 2) * kstep; const char* b2 = last ? nB : cB + (size_t)(t + 2) * kstep;
            const char* a3 = a2 + kstep; const char* b3 = b2 + kstep;
            PG8_LDB(B0, 0, 0); PG8_LDB(B1, 0, 1); PG8_SCHED; PG8_LDA(At, 0, 0); PG8_STAGE_A(PG8_SA(1, 1), a1, 1, false);
            PG8_WAIT_V(8); PG8_WAIT_L(0); PG8_BAR; PG8_MM(0, 0, At, B0); PG8_MM(0, 1, At, B1); PG8_BAR; PG8_SCHED;
            PG8_LDA(At, 0, 1); PG8_STAGE(PG8_SB(0, 0), b2, voffB); PG8_STAGE(PG8_SB(0, 1), b2 + hstepB, voffB); PG8_STAGE_A(PG8_SA(0, 0), a2, 0, last);
            PG8_WAIT_V(8); PG8_WAIT_L(0); PG8_BAR; PG8_MM(1, 0, At, B0); PG8_MM(1, 1, At, B1); PG8_BAR; PG8_SCHED;
            PG8_LDB(B0, 1, 0); PG8_LDB(B1, 1, 1); PG8_SCHED; PG8_LDA(At, 1, 0); PG8_STAGE_A(PG8_SA(0, 1), a2, 1, last);
            PG8_WAIT_V(8); PG8_WAIT_L(0); PG8_BAR; PG8_MM(0, 0, At, B0); PG8_MM(0, 1, At, B1); PG8_BAR; PG8_SCHED;
            PG8_LDA(At, 1, 1); PG8_STAGE(PG8_SB(1, 0), b3, voffB); PG8_STAGE(PG8_SB(1, 1), b3 + hstepB, voffB); PG8_STAGE_A(PG8_SA(1, 0), a3, 0, last);
            PG8_WAIT_V(8); PG8_WAIT_L(0); PG8_BAR; PG8_MM(1, 0, At, B0); PG8_MM(1, 1, At, B1); PG8_BAR; PG8_SCHED;
        }
        if constexpr (ALIGN_EPI) { if (wr == 0) PG8_BAR; }
        { int fr_ = fr, fq_ = fq; asm volatile("" : "+v"(fr_), "+v"(fq_)); P.epi(acc, cur, wr, wc, fr_, fq_); }
        if (!has_next) break;
#pragma unroll
        for (int a = 0; a < 2; ++a)
#pragma unroll
            for (int b = 0; b < 2; ++b)
#pragma unroll
                for (int m = 0; m < 4; ++m)
#pragma unroll
                    for (int n = 0; n < 2; ++n) acc[a][b][m][n] = (f32x4){0.f, 0.f, 0.f, 0.f};
        cur = nxt; cA = nA; cB = nB; ++ui;
        if constexpr (GATHER) { _Pragma("unroll") for (int h_ = 0; h_ < 2; ++h_) _Pragma("unroll") for (int i_ = 0; i_ < 2; ++i_) vgc[h_][i_] = vgn[h_][i_]; }
        if constexpr (ALIGN_EPI) { if (wr == 1) PG8_BAR; }
    }
    PG8_WAIT_V(0);
    if constexpr (!ALIGN_EPI) { if (wr == 0) PG8_BAR; }
    PG8_BAR;
#undef PG8_SA
#undef PG8_SB
#undef PG8_STAGE
#undef PG8_STAGE_A
#undef PG8_GLOAD
#undef PG8_LDA
#undef PG8_LDB
#undef PG8_MMA
#undef PG8_H0
#undef PG8_H1
#undef PG8_MMA8
#undef PG8_MM
#undef PG8_WAIT_V
#undef PG8_WAIT_L
#undef PG8_BAR
#undef PG8_SCHED
}
}
using pg8::Unit;
typedef const f32x4 (&AccRef)[2][2][4][2];

struct ProbBf16 {
    static constexpr bool PERM = true;
    const bf16_t* A; const bf16_t* Bt; bf16_t* O; int K, ldc;
    __device__ __forceinline__ int kloop() const { return K; }
    __device__ __forceinline__ const char* Aptr(const Unit& u) const { return (const char*)A + (size_t)u.pm * 256 * K * 2; }
    __device__ __forceinline__ const char* Bptr(const Unit& u) const { return (const char*)Bt + (size_t)u.pn * 256 * K * 2; }
    __device__ __forceinline__ void epi(AccRef acc, const Unit& u, int wr, int wc, int fr, int fq) const {
        const int row0 = u.pm * 256 + wr * 64 + fr, col0 = u.pn * 256 + wc * 32 + 8 * fq;
#pragma unroll
        for (int ai = 0; ai < 2; ++ai)
#pragma unroll
            for (int m = 0; m < 4; ++m) { bf16_t* rowp = O + (size_t)(row0 + ai * 128 + m * 16) * ldc + col0;
#pragma unroll
                for (int bj = 0; bj < 2; ++bj) { const f32x4 v0 = acc[ai][bj][m][0], v1 = acc[ai][bj][m][1];
                    u32x4 w; w.x = cvt_pk_bf16(v0[0], v0[1]); w.y = cvt_pk_bf16(v0[2], v0[3]); w.z = cvt_pk_bf16(v1[0], v1[1]); w.w = cvt_pk_bf16(v1[2], v1[3]);
                    *(u32x4*)(rowp + bj * 128) = w; } }
    }
};
struct ProbLora {
    static constexpr bool PERM = true;
    const bf16_t* A; const bf16_t* Bt; float* O; const float* w0; const float* a0; int K;
    __device__ __forceinline__ int kloop() const { int kl = 256; asm volatile("" : "+s"(kl)); return kl; }
    __device__ __forceinline__ const char* Aptr(const Unit& u) const { return (const char*)A + (size_t)u.pm * 256 * K * 2 + ((u.pn >> 2) == 4 ? 512 : 0); }
    __device__ __forceinline__ const char* Bptr(const Unit& u) const { return (const char*)Bt + (size_t)u.pn * 256 * K * 2 + ((u.pn >> 2) == 4 ? 512 : 0); }
    __device__ __forceinline__ void epi(AccRef acc, const Unit& u, int wr, int wc, int fr, int fq) const {
        const int type = u.pn >> 2, cb = (u.pn & 3) * 256 + wc * 32 + 8 * fq, row0 = u.pm * 256 + wr * 64 + fr;
        const float* bias = type < 2 ? w0 + type * RW : (type < 4 ? a0 + (type - 2) * RW : nullptr);
        float* Ob = O + (size_t)type * M * RW; bf16_t* Ob16 = (bf16_t*)(O + (size_t)2 * M * RW) + (size_t)(type - 2) * M * RW;
#pragma unroll
        for (int bj = 0; bj < 2; ++bj) { const int c = cb + bj * 128;
            const f32x4 z = (f32x4){0.f, 0.f, 0.f, 0.f}; const f32x4 bv0 = bias ? *(const f32x4*)(bias + c) : z, bv1 = bias ? *(const f32x4*)(bias + c + 4) : z;
#pragma unroll
            for (int ai = 0; ai < 2; ++ai)
#pragma unroll
                for (int m = 0; m < 4; ++m) { f32x4 v0 = acc[ai][bj][m][0] + bv0, v1 = acc[ai][bj][m][1] + bv1; const size_t ro = (size_t)(row0 + ai * 128 + m * 16) * RW + c;
                    if (type < 2) {
#pragma unroll
                        for (int j = 0; j < 4; ++j) { v0[j] = -0.60653066f * sigmoidf_(v0[j]); v1[j] = -0.60653066f * sigmoidf_(v1[j]); }
                        *(u32x4*)((unsigned short*)O + (size_t)type * M * RW + ro) = (u32x4){pkh2(v0[0], v0[1]), pkh2(v0[2], v0[3]), pkh2(v1[0], v1[1]), pkh2(v1[2], v1[3])};
                    } else {
                        if (type < 4) {
#pragma unroll
                            for (int j = 0; j < 4; ++j) { v0[j] = sigmoidf_(v0[j]); v1[j] = sigmoidf_(v1[j]); } }
                        *(u32x4*)(Ob16 + ro) = (u32x4){cvt_pk_bf16(v0[0], v0[1]), cvt_pk_bf16(v0[2], v0[3]), cvt_pk_bf16(v1[0], v1[1]), cvt_pk_bf16(v1[2], v1[3])}; } } }
    }
};
struct ProbRes {
    static constexpr bool PERM = true;
    const bf16_t* A; const bf16_t* Bt; const float* base; bf16_t* O; int K;
    __device__ __forceinline__ int kloop() const { return K; }
    __device__ __forceinline__ const char* Aptr(const Unit& u) const { return (const char*)A + (size_t)u.pm * 256 * K * 2; }
    __device__ __forceinline__ const char* Bptr(const Unit& u) const { return (const char*)Bt + (size_t)u.pn * 256 * K * 2; }
    __device__ __forceinline__ void epi(AccRef acc, const Unit& u, int wr, int wc, int fr, int fq) const {
        const int row0 = u.pm * 256 + wr * 64 + fr, col0 = u.pn * 256 + wc * 32 + 8 * fq;
#pragma unroll
        for (int ai = 0; ai < 2; ++ai)
#pragma unroll
            for (int m = 0; m < 4; ++m) { const size_t off = (size_t)(row0 + ai * 128 + m * 16) * D + col0;
#pragma unroll
                for (int bj = 0; bj < 2; ++bj) { const float* bp = base + off + bj * 128; const f32x4 r0 = *(const f32x4*)bp + acc[ai][bj][m][0], r1 = *(const f32x4*)(bp + 4) + acc[ai][bj][m][1];
                    *(u32x4*)(O + off + bj * 128) = (u32x4){cvt_pk_bf16(r0[0], r0[1]), cvt_pk_bf16(r0[2], r0[3]), cvt_pk_bf16(r1[0], r1[1]), cvt_pk_bf16(r1[2], r1[3])}; } }
    }
};
struct ProbGU {
    static constexpr bool PERM = true;
    const bf16_t* A; const bf16_t* Bt; bf16_t* O; const float* bgu; int K;
    __device__ __forceinline__ int kloop() const { return K; }
    __device__ __forceinline__ const char* Aptr(const Unit&) const { return (const char*)A; }
    __device__ __forceinline__ const char* Bptr(const Unit& u) const { return (const char*)Bt + ((size_t)u.e * 2 * DFF + (size_t)u.pn * 256) * K * 2; }
    __device__ __forceinline__ void epi(AccRef acc, const Unit& u, int wr, int wc, int fr, int fq) const {
        const int row0 = u.pm * 256 + wr * 64 + fr, f0 = u.pn * 128 + wc * 32 + 8 * fq;
        const float* bg = bgu + (size_t)u.e * 2 * DFF + f0;
        const f32x4 bgl0 = *(const f32x4*)bg, bgl1 = *(const f32x4*)(bg + 4), bup0 = *(const f32x4*)(bg + DFF), bup1 = *(const f32x4*)(bg + DFF + 4);
#pragma unroll
        for (int ai = 0; ai < 2; ++ai)
#pragma unroll
            for (int m = 0; m < 4; ++m) {
                float o[8];
#pragma unroll
                for (int n = 0; n < 2; ++n) { const f32x4 g4 = acc[ai][0][m][n] + (n ? bgl1 : bgl0), u4 = acc[ai][1][m][n] + (n ? bup1 : bup0);
#pragma unroll
                    for (int j = 0; j < 4; ++j) { const float gl = fminf(g4[j], 7.0f), up = fminf(fmaxf(u4[j], -7.0f), 7.0f);
                        o[4 * n + j] = (up + 1.0f) * gl * sigmoidf_(1.702f * gl); } }
                u32x2 w; w.x = pk4_fp8w(o[0] * FP8_MUL_X, o[1] * FP8_MUL_X, o[2] * FP8_MUL_X, o[3] * FP8_MUL_X); w.y = pk4_fp8w(o[4] * FP8_MUL_X, o[5] * FP8_MUL_X, o[6] * FP8_MUL_X, o[7] * FP8_MUL_X);
                *(u32x2*)((unsigned char*)O + (size_t)(row0 + ai * 128 + m * 16) * DFF + f0) = w; }
    }
};
struct ProbDN {
    static constexpr int PERM = 2;
    const bf16_t* A; const bf16_t* Bt; bf16_t* O; const float* bdn; const float* rgate; int K;
    __device__ __forceinline__ int kloop() const { return K; }
    __device__ __forceinline__ const char* Aptr(const Unit& u) const { return (const char*)A + (size_t)u.pm * 256 * K * 2; }
    __device__ __forceinline__ const char* Bptr(const Unit& u) const { return (const char*)Bt + ((size_t)u.e * D + (size_t)u.pn * 256) * K * 2; }
    __device__ __forceinline__ void epi(AccRef acc, const Unit& u, int wr, int wc, int fr, int fq) const {
        const int row0 = u.pm * 256 + wr * 64 + fr, col0 = u.pn * 256 + wc * 64 + 16 * fq;
        const float* bb = bdn + (size_t)u.e * D + col0;
        f32x4 bv[2][2];
#pragma unroll
        for (int bj = 0; bj < 2; ++bj)
#pragma unroll
            for (int n = 0; n < 2; ++n) bv[bj][n] = *(const f32x4*)(bb + bj * 8 + 4 * n);
#pragma unroll
        for (int ai = 0; ai < 2; ++ai)
#pragma unroll
            for (int m = 0; m < 4; ++m) { const int row = row0 + ai * 128 + m * 16; const float gt = rgate[row] * YB_MUL; unsigned char* rowp = (unsigned char*)O + (size_t)row * D + col0;
                u32x4 w;
#pragma unroll
                for (int bj = 0; bj < 2; ++bj) { const f32x4 v0 = (acc[ai][bj][m][0] + bv[bj][0]) * gt, v1 = (acc[ai][bj][m][1] + bv[bj][1]) * gt;
                    w[2 * bj] = pk4_fp8(v0[0], v0[1], v0[2], v0[3]); w[2 * bj + 1] = pk4_fp8(v1[0], v1[1], v1[2], v1[3]); }
                *(u32x4*)rowp = w; }
    }
};
struct ProbPLE {
    static constexpr bool PERM = true;
    const bf16_t* A; const bf16_t* Bt; const bf16_t* x2; const bf16_t* pp; bf16_t* O; int K;
    __device__ __forceinline__ int kloop() const { return K; }
    __device__ __forceinline__ const char* Aptr(const Unit& u) const { return (const char*)A + (size_t)u.pm * 256 * K * 2; }
    __device__ __forceinline__ const char* Bptr(const Unit& u) const { return (const char*)Bt + (size_t)u.pn * 256 * K * 2; }
    __device__ __forceinline__ void epi(AccRef acc, const Unit& u, int wr, int wc, int fr, int fq) const {
        const int row0 = u.pm * 256 + wr * 64 + fr, col0 = u.pn * 256 + wc * 32 + 8 * fq;
#pragma unroll
        for (int ai = 0; ai < 2; ++ai)
#pragma unroll
            for (int m = 0; m < 4; ++m) { const size_t off = (size_t)(row0 + ai * 128 + m * 16) * D + col0;
#pragma unroll
                for (int bj = 0; bj < 2; ++bj) { const size_t o = off + bj * 128; float xb[8], pv[8], r[8]; unpack8(*(const u32x4*)(x2 + o), xb); unpack8(*(const u32x4*)(pp + o), pv);
#pragma unroll
                    for (int n = 0; n < 2; ++n)
#pragma unroll
                        for (int j = 0; j < 4; ++j) r[4 * n + j] = xb[4 * n + j] + sigmoidf_(acc[ai][bj][m][n][j]) * pv[4 * n + j];
                    *(u32x4*)(O + o) = (u32x4){cvt_pk_bf16(r[0], r[1]), cvt_pk_bf16(r[2], r[3]), cvt_pk_bf16(r[4], r[5]), cvt_pk_bf16(r[6], r[7])}; } }
    }
};

#define XB_TMO      128
#define XB_XCNT(j)  (256  + 64 * (j))
#define XB_XSUB(j)  (1280 + 64 * (j))
#define XB_XGEN(j)  (2304 + 64 * (j))
#define XB_TOP      3328
#define XB_TOPGEN   3392
#define XCD_BAR_WORDS 3456
#define XB_SPIN_CAP (1u << 18)
__device__ __forceinline__ unsigned xb_ld(unsigned* p)              { return __hip_atomic_load(p, __ATOMIC_RELAXED, __HIP_MEMORY_SCOPE_AGENT); }
__device__ __forceinline__ unsigned xb_add(unsigned* p, unsigned v) { return __hip_atomic_fetch_add(p, v, __ATOMIC_RELAXED, __HIP_MEMORY_SCOPE_AGENT); }
__device__ __forceinline__ unsigned xb_xcc_id() { return (unsigned)__builtin_amdgcn_s_getreg((3 << 11) | 20) & 0xFu; }
#define XB_SPIN(cond, bar) do { unsigned _sp = 0; while (cond) { __builtin_amdgcn_s_sleep(1); \
    if ((++_sp & 255u) == 0u) { if (xb_ld(&(bar)[XB_TMO])) break; if (_sp > XB_SPIN_CAP) { atomicAdd(&(bar)[XB_TMO], 1u); break; } } } } while (0)
struct XcdBarrier { unsigned* bar; unsigned x; volatile LAS unsigned* st; };
__device__ __forceinline__ XcdBarrier xcd_barrier_post(unsigned* bar, volatile LAS unsigned* st) {
    XcdBarrier b; b.bar = bar; b.x = xb_xcc_id(); b.st = st;
    if (threadIdx.x == 0) (void)xb_add(&bar[XB_XCNT(b.x)], 1u);
    return b;
}
__device__ __forceinline__ void xcd_barrier_complete(unsigned* bar, unsigned x, unsigned& nloc, unsigned& nx) {
    const unsigned G = gridDim.x * gridDim.y * gridDim.z;
    unsigned sum, cnt, mine, sp = 0u;
    for (;;) {
        sum = 0u; cnt = 0u; mine = 0u;
#pragma unroll
        for (unsigned j = 0; j < 16; ++j) { const unsigned c = xb_ld(&bar[XB_XCNT(j)]); sum += c; cnt += (c > 0u) ? 1u : 0u; mine = (j == x) ? c : mine; }
        if (sum == G) break;
        __builtin_amdgcn_s_sleep(1);
        if ((++sp & 255u) == 0u) { if (xb_ld(&bar[XB_TMO])) break; if (sp > XB_SPIN_CAP) { atomicAdd(&bar[XB_TMO], 1u); break; } }
    }
    nloc = mine > 0u ? mine : 1u; nx = cnt > 0u ? cnt : 1u;
}
__device__ __forceinline__ void xcd_barrier(const XcdBarrier& b) {
    asm volatile("s_waitcnt vmcnt(0)" ::: "memory");
    __syncthreads();
    if (threadIdx.x == 0) {
        unsigned* bar = b.bar;
        __builtin_amdgcn_s_waitcnt(0);
        unsigned nloc = b.st[0], nx = b.st[1];
        if (nloc == 0u) { xcd_barrier_complete(bar, b.x, nloc, nx); b.st[0] = nloc; b.st[1] = nx; }
        const unsigned old = xb_add(&bar[XB_XSUB(b.x)], 1u);
        const unsigned gen = old / nloc;
        if (old + 1u == (gen + 1u) * nloc) {
            __builtin_amdgcn_fence(__ATOMIC_RELEASE, "agent");
            asm volatile("s_waitcnt vmcnt(0)" ::: "memory");
            const unsigned og = xb_add(&bar[XB_TOP], 1u);
            const unsigned tg = og / nx;
            if (og + 1u == (tg + 1u) * nx) xb_add(&bar[XB_TOPGEN], 1u);
            else XB_SPIN(xb_ld(&bar[XB_TOPGEN]) == tg, bar);
            __builtin_amdgcn_fence(__ATOMIC_ACQUIRE, "agent");
            xb_add(&bar[XB_XGEN(b.x)], 1u);
            asm volatile("s_waitcnt vmcnt(0)" ::: "memory");
        } else {
            XB_SPIN(xb_ld(&bar[XB_XGEN(b.x)]) == gen, bar);
            __builtin_amdgcn_fence(__ATOMIC_ACQUIRE, "agent");
            asm volatile("s_waitcnt vmcnt(0)" ::: "memory");
        }
    }
    __syncthreads();
}

struct Ctx { LAS unsigned char* lds; int tid, lane, wave, vb, nvb; };

__device__ __forceinline__ void transpose_item(const float* W, int N, bf16_t* WT, int ldk, int drow0, LAS float* scr, int k0, int n0, int lane) {
    float vv[32]; const float* wp = W + (size_t)(k0 + (lane >> 5)) * N + n0 + (lane & 31);
#pragma unroll
    for (int i = 0; i < 32; ++i) vv[i] = wp[(size_t)(2 * i) * N];
#pragma unroll
    for (int i = 0; i < 32; ++i) scr[(2 * i + (lane >> 5)) * 33 + (lane & 31)] = vv[i];
    LDS_WAIT(); asm volatile("" ::: "memory");
    const int c = lane & 7;
#pragma unroll
    for (int j = 0; j < 4; ++j) { const int n = (lane >> 3) + 8 * j; const LAS float* s = scr + (8 * c) * 33 + n;
        u32x4 o; o.x = pk2(s[0 * 33], s[1 * 33]); o.y = pk2(s[2 * 33], s[3 * 33]); o.z = pk2(s[4 * 33], s[5 * 33]); o.w = pk2(s[6 * 33], s[7 * 33]);
        *(u32x4*)(WT + (size_t)(drow0 + n) * ldk + k0 + 8 * c) = o; }
    LDS_WAIT(); asm volatile("" ::: "memory");
}
__device__ __forceinline__ void transpose_item8(const float* W, int N, unsigned char* WT, int ldk, int drow0, LAS float* scr, int k0, int n0, int lane) {
    float vv[32]; const float* wp = W + (size_t)(k0 + (lane >> 5)) * N + n0 + (lane & 31);
#pragma unroll
    for (int i = 0; i < 32; ++i) vv[i] = wp[(size_t)(2 * i) * N];
#pragma unroll
    for (int i = 0; i < 32; ++i) scr[(2 * i + (lane >> 5)) * 33 + (lane & 31)] = vv[i] * FP8_MUL_W;
    LDS_WAIT(); asm volatile("" ::: "memory");
    const int c = lane & 7;
#pragma unroll
    for (int j = 0; j < 4; ++j) { const int n = (lane >> 3) + 8 * j; const LAS float* s = scr + (8 * c) * 33 + n;
        u32x2 o; o.x = pk4_fp8w(s[0 * 33], s[1 * 33], s[2 * 33], s[3 * 33]); o.y = pk4_fp8w(s[4 * 33], s[5 * 33], s[6 * 33], s[7 * 33]);
        *(u32x2*)(WT + (size_t)(drow0 + n) * ldk + k0 + 8 * c) = o; }
    LDS_WAIT(); asm volatile("" ::: "memory");
}
__device__ __forceinline__ void rms_row_bf16(const float* xrow, const float* g, bf16_t* orow, int lane) {
    const f32x4* xr = (const f32x4*)xrow + lane; f32x4 v[8]; float s = 0.f;
#pragma unroll
    for (int j = 0; j < 8; ++j) { v[j] = xr[64 * j]; s += (v[j].x * v[j].x + v[j].y * v[j].y) + (v[j].z * v[j].z + v[j].w * v[j].w); }
    const float rstd = 1.0f / sqrtf(wave_sum(s) * (1.0f / D) + RMS_EPS);
    unsigned long long* o8 = (unsigned long long*)orow + lane;
#pragma unroll
    for (int j = 0; j < 8; ++j) { const f32x4 gg = ((const f32x4*)g)[lane + 64 * j];
        o8[64 * j] = (unsigned long long)pk2(v[j].x * rstd * gg.x, v[j].y * rstd * gg.y) | ((unsigned long long)pk2(v[j].z * rstd * gg.z, v[j].w * rstd * gg.w) << 32); }
}

__device__ __forceinline__ void rms_regs_bf16(const f32x4 (&v)[8], const float* g, bf16_t* orow, int lane) {
    float s = 0.f;
#pragma unroll
    for (int j = 0; j < 8; ++j) s += (v[j].x * v[j].x + v[j].y * v[j].y) + (v[j].z * v[j].z + v[j].w * v[j].w);
    const float rstd = 1.0f / sqrtf(wave_sum(s) * (1.0f / D) + RMS_EPS);
    unsigned long long* o8 = (unsigned long long*)orow + lane;
#pragma unroll
    for (int j = 0; j < 8; ++j) { const f32x4 gg = ((const f32x4*)g)[lane + 64 * j];
        o8[64 * j] = (unsigned long long)pk2(v[j].x * rstd * gg.x, v[j].y * rstd * gg.y) | ((unsigned long long)pk2(v[j].z * rstd * gg.z, v[j].w * rstd * gg.w) << 32); }
}

namespace cv {
constexpr int I_IN = (D / 128) * (NIN / 32);
constexpr int I_OUT = (D / 128) * (D / 32);
constexpr int I_GU1 = (D / 128) * (2 * DFF / 32);
constexpr int I_DN1 = (DFF / 128) * (D / 32);
constexpr int I_PG = I_OUT;
constexpr int I_PP = (PLE / 128) * (D / 32);
constexpr int NITEMS = I_IN + I_OUT + NE * I_GU1 + NE * I_DN1 + I_PG + I_PP;
constexpr int EXP_A = I_IN + I_OUT;
#ifndef CONV_MOVED
#define CONV_MOVED 98304
#endif
constexpr int MOVED = CONV_MOVED;
static_assert(MOVED <= NE * (I_GU1 + I_DN1), "moved items are expert items");
struct ItemD { const float* src; size_t rs; unsigned char* dst; int ldk; int f8; };
__device__ __forceinline__ void decode(const Prm& p, int lane, int it, ItemD& d) {
    unsigned char* ws = p.ws; int r = it; const int l5 = lane >> 5, l31 = lane & 31;
    if (r < I_IN) { const int nblk = NIN / 32, kb = r / nblk, nb = r % nblk; d.src = p.in[3] + (size_t)(128 * kb + l5) * NIN + 32 * nb + l31; d.rs = (size_t)2 * NIN; d.dst = ws + WS_WIN + ((size_t)(32 * nb) * D + 128 * kb) * 2; d.ldk = D * 2; d.f8 = 0; return; } r -= I_IN;
    if (r < I_OUT) { const int nblk = D / 32, kb = r / nblk, nb = r % nblk; d.src = p.in[16] + (size_t)(128 * kb + l5) * D + 32 * nb + l31; d.rs = (size_t)2 * D; d.dst = ws + WS_WOUT + ((size_t)(32 * nb) * D + 128 * kb) * 2; d.ldk = D * 2; d.f8 = 0; return; } r -= I_OUT;
    if (r < NE * I_GU1) { const int e = r / I_GU1, q = r % I_GU1, nblk = 2 * DFF / 32, kb = q / nblk, nb = q % nblk, n0 = 32 * nb;
        const int bj = n0 / DFF, j = n0 % DFF, pn = j / 128, cc = j % 128, drow0 = pn * 256 + bj * 128 + cc;
        d.src = p.in[20] + (size_t)e * D * 2 * DFF + (size_t)(128 * kb + l5) * (2 * DFF) + n0 + l31; d.rs = (size_t)4 * DFF; d.dst = ws + WS_WGU + (size_t)e * 2 * DFF * D + (size_t)drow0 * D + 128 * kb; d.ldk = D; d.f8 = 1; return; } r -= NE * I_GU1;
    if (r < NE * I_DN1) { const int e = r / I_DN1, q = r % I_DN1, nblk = D / 32, kb = q / nblk, nb = q % nblk;
        d.src = p.in[22] + (size_t)e * DFF * D + (size_t)(128 * kb + l5) * D + 32 * nb + l31; d.rs = (size_t)2 * D; d.dst = ws + WS_WDN + (size_t)e * D * DFF + (size_t)(32 * nb) * DFF + 128 * kb; d.ldk = DFF; d.f8 = 1; return; } r -= NE * I_DN1;
    if (r < I_PG) { const int nblk = D / 32, kb = r / nblk, nb = r % nblk; d.src = p.in[25] + (size_t)(128 * kb + l5) * D + 32 * nb + l31; d.rs = (size_t)2 * D; d.dst = ws + WS_WPG + (size_t)(32 * nb) * D + 128 * kb; d.ldk = D; d.f8 = 1; return; } r -= I_PG;
    { const int nblk = D / 32, kb = r / nblk, nb = r % nblk; d.src = p.in[26] + (size_t)(128 * kb + l5) * D + 32 * nb + l31; d.rs = (size_t)2 * D; d.dst = ws + WS_WPP + ((size_t)(32 * nb) * PLE + 128 * kb) * 2; d.ldk = PLE * 2; d.f8 = 0; }
}
__device__ __forceinline__ void loop(const Prm& p, const Ctx& c, int q0, int nq, int qs, int skipA, int skip) {
    LAS float* scr = (LAS float*)(c.lds + c.wave * 16384);
#define CV_IT(q_) ((q_) + ((q_) >= skipA ? skip : 0))
    if (q0 < nq) {
        ItemD cur; decode(p, c.lane, CV_IT(q0), cur); float va[2][32];
#pragma unroll
        for (int h = 0; h < 2; ++h)
#pragma unroll
            for (int i = 0; i < 32; ++i) va[h][i] = __builtin_nontemporal_load(cur.src + (size_t)(32 * h + i) * cur.rs);
        for (int q = q0; q < nq; q += qs) {
            const bool more = q + qs < nq; ItemD nxt = cur; float vb[2][32];
            if (more) { decode(p, c.lane, CV_IT(q + qs), nxt);
#pragma unroll
                for (int h = 0; h < 2; ++h)
#pragma unroll
                    for (int i = 0; i < 32; ++i) vb[h][i] = __builtin_nontemporal_load(nxt.src + (size_t)(32 * h + i) * nxt.rs); }
            const float mul = cur.f8 ? FP8_MUL_W : 1.0f;
#pragma unroll
            for (int h = 0; h < 2; ++h) {
#pragma unroll
                for (int i = 0; i < 32; ++i) scr[(2 * i + (c.lane >> 5)) * 33 + (c.lane & 31)] = va[h][i] * mul;
                LDS_WAIT(); asm volatile("" ::: "memory");
                { const int cc = c.lane & 7;
#pragma unroll
                  for (int j = 0; j < 4; ++j) { const int n = (c.lane >> 3) + 8 * j; const LAS float* sp = scr + (8 * cc) * 33 + n;
                      const float t0 = sp[0 * 33], t1 = sp[1 * 33], t2 = sp[2 * 33], t3 = sp[3 * 33], t4 = sp[4 * 33], t5 = sp[5 * 33], t6 = sp[6 * 33], t7 = sp[7 * 33];
                      if (cur.f8) { u32x2 o; o.x = pk4_fp8w(t0, t1, t2, t3); o.y = pk4_fp8w(t4, t5, t6, t7); *(u32x2*)(cur.dst + (size_t)n * cur.ldk + 64 * h + 8 * cc) = o; }
                      else { u32x4 o; o.x = pk2(t0, t1); o.y = pk2(t2, t3); o.z = pk2(t4, t5); o.w = pk2(t6, t7); *(u32x4*)(cur.dst + (size_t)n * cur.ldk + 128 * h + 16 * cc) = o; } } }
                LDS_WAIT(); asm volatile("" ::: "memory");
            }
            if (more) { cur = nxt;
#pragma unroll
                for (int h = 0; h < 2; ++h)
#pragma unroll
                    for (int i = 0; i < 32; ++i) va[h][i] = vb[h][i]; }
        }
    }
#undef CV_IT
}
constexpr int RUN_GU = NE * I_GU1;
constexpr int RUN_DN = NE * I_DN1;
constexpr int NRUN = RUN_GU + RUN_DN;
#ifndef CW1
#define CW1 6
#define CW2 14
#define CW3 3
#define CW7 3
#endif
#ifndef PA_CONV
#define PA_CONV 1
#endif
constexpr int SLOT_BASE = PA_CONV ? NE * I_GU1 : 0;
constexpr int P1_NU = (M / 256) * (NINP / 256);
__device__ __forceinline__ void slot_split(int nvb, int vb, int& moved, int& start, int& cnt) {
    const int numax = (P1_NU + nvb - 1) / nvb, r = P1_NU - (numax - 1) * nvb, total = (r * CW1 + (nvb - r) * CW2) * NWAVES;
    moved = SLOT_BASE + total < NE * (I_GU1 + I_DN1) ? SLOT_BASE + total : NE * (I_GU1 + I_DN1);
    start = SLOT_BASE + (vb < r ? vb * CW1 : r * CW1 + (vb - r) * CW2) * NWAVES; cnt = vb < r ? CW1 : CW2;
}
__device__ __forceinline__ int slot_total(int nvb) { int m1, s_, c_; slot_split(nvb, 0, m1, s_, c_); const int t = m1 + nvb * NWAVES * (CW3 + CW7); return t < NE * (I_GU1 + I_DN1) ? t : NE * (I_GU1 + I_DN1); }

struct SubD { const f32x4* src; unsigned char* dst; int rs4; };
__device__ __forceinline__ void sub_decode(const Prm& p, int lane, int r, SubD& d) {
    unsigned char* ws = p.ws; const int kq = lane >> 3, nq = lane & 7;
    if (r < RUN_GU) { const int e = r / I_GU1, q = r % I_GU1, nblk = 2 * DFF / 32, kb = q / nblk, nb = q % nblk, n0 = 32 * nb, k0 = 128 * kb + 16 * kq;
        const int bj = n0 / DFF, j = (n0 % DFF) + 4 * nq, drow = (j >> 7) * 256 + bj * 128 + (j & 127);
        d.src = (const f32x4*)(p.in[20] + (size_t)e * D * 2 * DFF + (size_t)k0 * (2 * DFF) + n0 + 4 * nq); d.rs4 = 2 * DFF / 4;
        d.dst = ws + WS_WGU + (size_t)e * 2 * DFF * D + (size_t)drow * D + k0; }
    else { const int r2 = r - RUN_GU, e = r2 / I_DN1, q = r2 % I_DN1, nblk = D / 32, kb = q / nblk, nb = q % nblk, n0 = 32 * nb, k0 = 128 * kb + 16 * kq;
        d.src = (const f32x4*)(p.in[22] + (size_t)e * DFF * D + (size_t)k0 * D + n0 + 4 * nq); d.rs4 = D / 4;
        d.dst = ws + WS_WDN + (size_t)e * D * DFF + (size_t)(n0 + 4 * nq) * DFF + k0; }
}
__device__ __forceinline__ void stream8(const Prm& p, const Ctx& c, int w0, int nw, int run_lo, int run_hi) {
    const int span = run_hi - run_lo; if (w0 >= span) return;
    const int n = (span - w0 + nw - 1) / nw;
    f32x4 A[16], B[16], C[16]; SubD dA, dB, dC;
#define CV_ISSUE(BUF, DD, t_) do { sub_decode(p, c.lane, __builtin_amdgcn_readfirstlane(run_lo + w0 + (t_) * nw), DD); _Pragma("unroll") for (int i = 0; i < 16; ++i) BUF[i] = __builtin_nontemporal_load(DD.src + (size_t)i * DD.rs4); } while (0)
#define CV_Q(BUF, i0, ee) pk4_fp8w(BUF[i0][ee] * FP8_MUL_W, BUF[i0 + 1][ee] * FP8_MUL_W, BUF[i0 + 2][ee] * FP8_MUL_W, BUF[i0 + 3][ee] * FP8_MUL_W)
#define CV_CONSUME(BUF, DD) do { _Pragma("unroll") for (int ee = 0; ee < 4; ++ee) { u32x4 o; o.x = CV_Q(BUF, 0, ee); o.y = CV_Q(BUF, 4, ee); o.z = CV_Q(BUF, 8, ee); o.w = CV_Q(BUF, 12, ee); \
        *(u32x4*)(DD.dst + (size_t)ee * D) = o; } } while (0)
    int t = 0;
    if (n >= 5) {
        CV_ISSUE(A, dA, 0); CV_ISSUE(B, dB, 1);
#pragma unroll 1
        for (; t + 4 < n; t += 3) {
            CV_ISSUE(C, dC, t + 2); CV_CONSUME(A, dA);
            CV_ISSUE(A, dA, t + 3); CV_CONSUME(B, dB);
            CV_ISSUE(B, dB, t + 4); CV_CONSUME(C, dC);
        }
    } else { CV_ISSUE(A, dA, 0); if (n > 1) CV_ISSUE(B, dB, 1); }
#pragma unroll 1
    for (; t < n; t += 3) {
        if (t + 2 < n) CV_ISSUE(C, dC, t + 2);
        CV_CONSUME(A, dA);
        if (t + 1 < n) { if (t + 3 < n) CV_ISSUE(A, dA, t + 3); CV_CONSUME(B, dB); }
        if (t + 2 < n) { if (t + 4 < n) CV_ISSUE(B, dB, t + 4); CV_CONSUME(C, dC); }
    }
#undef CV_ISSUE
#undef CV_Q
#undef CV_CONSUME
}
}

__device__ __forceinline__ void ph_prologue(const Prm& p, const Ctx& c) {
    unsigned char* ws = p.ws;
    const int gw = c.vb * NWAVES + c.wave, NGW = c.nvb * NWAVES;
    cv::loop(p, c, gw, cv::NITEMS - NE * (cv::I_GU1 + cv::I_DN1), NGW, cv::EXP_A, NE * (cv::I_GU1 + cv::I_DN1));
    cv::stream8(p, c, gw, NGW, cv::slot_total(c.nvb), cv::NRUN);
    const int gt = c.vb * NTHR + c.tid, NGT = c.nvb * NTHR;
    { u32x4* z = (u32x4*)((bf16_t*)(ws + WS_WIN) + (size_t)NIN * D); const int n16 = (NINP - NIN) * D * 2 / 16;
      for (int i = gt; i < n16; i += NGT) z[i] = (u32x4){0u, 0u, 0u, 0u}; }
    { unsigned* o = (unsigned*)(ws + WS_WLORA); const float *w2 = p.in[6], *a2 = p.in[8], *g2 = p.in[9];
      for (int i = gt; i < LNN * LK / 2; i += NGT) { const int n = i / (LK / 2), k = (i % (LK / 2)) * 2, type = n >> 10, cc = n & 1023; float v0 = 0.f, v1 = 0.f;
          if (type == 0 && k < 64) { v0 = w2[(size_t)k * RW + cc]; v1 = w2[(size_t)(k + 1) * RW + cc]; }
          else if (type == 1 && k >= 64 && k < 128) { v0 = w2[(size_t)(64 + k - 64) * RW + cc]; v1 = w2[(size_t)(64 + k - 63) * RW + cc]; }
          else if (type == 2 && k >= 128 && k < 192) { v0 = a2[(size_t)(k - 128) * RW + cc]; v1 = a2[(size_t)(k - 127) * RW + cc]; }
          else if (type == 3 && k >= 192 && k < 256) { v0 = a2[(size_t)(64 + k - 192) * RW + cc]; v1 = a2[(size_t)(64 + k - 191) * RW + cc]; }
          else if (type == 4 && k >= 256 && k < 416) { v0 = g2[(size_t)(k - 256) * RW + cc]; v1 = g2[(size_t)(k - 255) * RW + cc]; }
          o[i] = pk2(v0, v1); } }
    { bf16_t* o = (bf16_t*)(ws + WS_RWT); const float *rw = p.in[18], *g = p.in[17];
      for (int i = gt; i < D * NE; i += NGT) { const int k = i >> 5, e = i & 31; const float wv = rw[i] * g[k];
          const unsigned h0 = f2bf(wv); const float r1 = wv - __uint_as_float(h0 << 16); const unsigned h1 = f2bf(r1); const float r2 = r1 - __uint_as_float(h1 << 16); const unsigned h2 = f2bf(r2);
          o[(size_t)e * D + k] = (bf16_t)h0; o[(size_t)(NE + e) * D + k] = (bf16_t)h1; o[(size_t)(2 * NE + e) * D + k] = (bf16_t)h2; } }
    { const f32x4* s = (const f32x4*)p.in[1]; u32x2* o = (u32x2*)(ws + WS_PBF);
      for (int i = gt; i < M * PLE / 4; i += NGT) { const f32x4 v = s[i]; o[i] = (u32x2){pk2(v.x, v.y), pk2(v.z, v.w)}; } }
    for (int m = gw; m < M; m += 2 * NGW) {
        const bool two = m + NGW < M; const int m1 = two ? m + NGW : m;
        const f32x4* xa = (const f32x4*)(p.in[0] + (size_t)m * D) + c.lane; const f32x4* xb = (const f32x4*)(p.in[0] + (size_t)m1 * D) + c.lane; f32x4 va[8], vb2[8];
#pragma unroll
        for (int j = 0; j < 8; ++j) va[j] = xa[64 * j];
#pragma unroll
        for (int j = 0; j < 8; ++j) vb2[j] = xb[64 * j];
        rms_regs_bf16(va, p.in[2], (bf16_t*)(ws + WS_H) + (size_t)m * D, c.lane);
        if (two) rms_regs_bf16(vb2, p.in[2], (bf16_t*)(ws + WS_H) + (size_t)m1 * D, c.lane);
    }
}

__device__ __forceinline__ void ph_gemm_in(const Prm& p, const Ctx& c) {
    unsigned char* ws = p.ws;
    { ProbBf16 P{(const bf16_t*)(ws + WS_H), (const bf16_t*)(ws + WS_WIN), (bf16_t*)(ws + WS_P), D, NINP};
      pg8::Order S; S.init(M / 256, NINP / 256, c.nvb, c.vb, nullptr);
      constexpr int NU = cv::P1_NU;
      const int nu = c.vb < NU ? (NU - 1 - c.vb) / c.nvb + 1 : 0;
      int moved, cstart, ccnt; cv::slot_split(c.nvb, c.vb, moved, cstart, ccnt);
      int spos = (c.vb >> 3) & 7; if (spos > nu) spos = nu;
#pragma unroll 1
      for (int seg = 0; seg < 2; ++seg) {
          S.lo = seg ? spos : 0; S.hi = seg ? nu : spos;
          pg8::gemm_phase<ProbBf16, true>(c.lds, P, S);
          if (seg == 0) {
              const int b0 = cstart + c.wave * ccnt, b1 = b0 + ccnt < moved ? b0 + ccnt : moved;
              int one = 1; asm volatile("" : "+s"(one));
              cv::stream8(p, c, 0, one, b0, b1);
              VM_WAIT(); __syncthreads();
          }
      } }
    { ProbBf16 P{(const bf16_t*)(ws + WS_PBF), (const bf16_t*)(ws + WS_WPP), (bf16_t*)(ws + WS_PP), PLE, D};
      pg8::Order S; S.init(M / 256, D / 256, c.nvb, c.vb, nullptr); pg8::gemm_phase<ProbBf16, true>(c.lds, P, S); }
}

__device__ __forceinline__ void ph_lora_in(const Prm& p, const Ctx& c) {
    unsigned char* ws = p.ws; const bf16_t* Pm = (const bf16_t*)(ws + WS_P); bf16_t* LA = (bf16_t*)(ws + WS_LA); const float* mu = p.in[4];
    const int gw = c.vb * NWAVES + c.wave, NGW = c.nvb * NWAVES, cc = c.lane * 8;
    float mm[8] = {0.f, 0.f, 0.f, 0.f, 0.f, 0.f, 0.f, 0.f};
    if (cc < 416) { const f32x4 m0 = *(const f32x4*)(mu + 3 * RW + cc), m1 = *(const f32x4*)(mu + 3 * RW + cc + 4); mm[0] = m0.x; mm[1] = m0.y; mm[2] = m0.z; mm[3] = m0.w; mm[4] = m1.x; mm[5] = m1.y; mm[6] = m1.z; mm[7] = m1.w; }
    for (int tok0 = gw; tok0 < M; tok0 += 4 * NGW) {
        u32x4 ra[4], rp[4], rn[4]; const u32x4 z4 = (u32x4){0u, 0u, 0u, 0u};
#pragma unroll
        for (int q = 0; q < 4; ++q) { const int tok = tok0 + q * NGW; ra[q] = z4; rp[q] = z4; rn[q] = z4;
            if (tok < M && cc < 416) { const int t = tok % T; const bf16_t* row = Pm + (size_t)tok * NINP + 3 * RW + cc;
                ra[q] = *(const u32x4*)row; if (t > 0) rp[q] = *(const u32x4*)(row - NINP); if (t < T - 1) rn[q] = *(const u32x4*)(row + NINP); } }
#pragma unroll
        for (int q = 0; q < 4; ++q) { const int tok = tok0 + q * NGW; if (tok >= M) break;
            float a[8], pm[8], pn[8], z[8]; unpack8(ra[q], a); unpack8(rp[q], pm); unpack8(rn[q], pn);
#pragma unroll
            for (int i = 0; i < 8; ++i) { z[i] = a[i] + (0.5f * (pm[i] + pn[i]) - a[i]) * mm[i];
                if (cc < 128) z[i] = 2.0f * sigmoidf_(2.0f * z[i]) - 1.0f;
                else if (cc >= 256) z[i] = sigmoidf_(z[i]); }
            u32x4 o = (u32x4){pk2(z[0], z[1]), pk2(z[2], z[3]), pk2(z[4], z[5]), pk2(z[6], z[7])};
            if (cc >= 416) o = z4;
            *(u32x4*)(LA + (size_t)tok * LK + cc) = o; }
    }
}

template <class Prob>
__device__ __forceinline__ void gemm_with_slot(const Prm& p, const Ctx& c, const Prob& P, pg8::Order& S, int nunits, int spos, int off, int cw) {
    const int nu = c.vb < nunits ? (nunits - 1 - c.vb) / c.nvb + 1 : 0; if (spos > nu) spos = nu;
    const int lim = NE * (cv::I_GU1 + cv::I_DN1);
#pragma unroll 1
    for (int seg = 0; seg < 2; ++seg) {
        S.lo = seg ? spos : 0; S.hi = seg ? nu : spos;
        pg8::gemm_phase<Prob, true>(c.lds, P, S);
        if (seg == 0 && cw > 0) {
            int b0 = off + (c.vb * NWAVES + c.wave) * cw, b1 = b0 + cw; if (b0 > lim) b0 = lim; if (b1 > lim) b1 = lim;
            int one = 1; asm volatile("" : "+s"(one));
            cv::stream8(p, c, 0, one, b0, b1);
            VM_WAIT(); __syncthreads();
        }
    }
}
__device__ __forceinline__ void ph_gemm_lora(const Prm& p, const Ctx& c) {
    unsigned char* ws = p.ws;
    ProbLora P{(const bf16_t*)(ws + WS_LA), (const bf16_t*)(ws + WS_WLORA), (float*)(ws + WS_LOUT), p.in[5], p.in[7], LK};
    pg8::Order S; S.init(M / 256, LNN / 256, c.nvb, c.vb, nullptr);
    { int m1, s_, c_; cv::slot_split(c.nvb, c.vb, m1, s_, c_); gemm_with_slot<ProbLora>(p, c, P, S, (M / 256) * (LNN / 256), (c.vb >> 3) % 6, m1, CW3); }
}

typedef short bf16x4 __attribute__((ext_vector_type(4)));
typedef __bf16 bfv4_t __attribute__((ext_vector_type(4)));
__device__ __forceinline__ bf16x4 pack4(const f32x4 v) { const bfv4_t b = __builtin_convertvector(v, bfv4_t); return __builtin_bit_cast(bf16x4, b); }
__device__ __forceinline__ f32x4 unpack4(const bf16x4 b) { const u32x2 w = __builtin_bit_cast(u32x2, b); return (f32x4){bf_lo(w.x), bf_hi(w.x), bf_lo(w.y), bf_hi(w.y)}; }
__device__ __forceinline__ bf16x8 cat8(const bf16x4 lo, const bf16x4 hi) { return __builtin_shufflevector(lo, hi, 0, 1, 2, 3, 4, 5, 6, 7); }
__device__ __forceinline__ f32x4 mfma32(const bf16x8 a, const bf16x8 b, const f32x4 c) {
    f32x4 d; asm volatile("s_nop 1\n\tv_mfma_f32_16x16x32_bf16 %0, %1, %2, %3\n\ts_nop 7" : "=&v"(d) : "v"(a), "v"(b), "v"(c)); return d; }

constexpr int CRS = 144;
constexpr int L_AT = 0, L_BT = 9216, L_KT = 18432, L_RT = 27648;
constexpr int L_AF = 36864, L_BHF = 45056, L_KHF = 53248, L_VF = 61440;
constexpr int L_MAB = 69632, L_MAK = 78848, L_MRB = 88064, L_MRK = 97280;
constexpr int L_MTI = 106496;
constexpr int L_GL = 109568;
constexpr int L_TOT = 109824;
static_assert(L_TOT + 4096 <= LDS_STAGE, "chunk LDS map");

__device__ __forceinline__ float zshift(float a, float pm, float pn, float mu) { return a + (0.5f * (pm + pn) - a) * mu; }
__device__ __forceinline__ void ph_chunk_pre(const Prm& p, const Ctx& c) {
    unsigned char* ws = p.ws; const bf16_t* Pm = (const bf16_t*)(ws + WS_P); const float* mu = p.in[4]; const unsigned short* LOUT = (const unsigned short*)(ws + WS_LOUT); const bf16_t* LOB = (const bf16_t*)(ws + WS_LOB);
    LAS unsigned char* lds = c.lds;
    const int lane = c.lane, m16 = lane & 15, g = lane >> 4, w = c.wave;
    const int tq = c.tid >> 5, kp = c.tid & 31, k0 = 2 * kp;
    const bf16x4 zero4 = (bf16x4){0, 0, 0, 0};
    unsigned Lp[6], Lk[6], Lv[6], Lap[4], Llp[4], Lap1[4];
#define PA_ISSUE(it_) do { const int h_ = (it_) & 15, ch_ = ((it_) >> 4) & 63, b_ = ((it_) >> 10) & 3, d_ = (it_) >> 12; \
        const int col_ = h_ * HS + k0, pos0_ = 64 * ch_ + 4 * tq, ttf_ = d_ ? (T - 1 - (pos0_ + 3)) : pos0_; \
        _Pragma("unroll") for (int rho = 0; rho < 6; ++rho) { const int tt = ttf_ - 1 + rho; unsigned a_ = 0u, b2_ = 0u, c2_ = 0u; \
            if (tt >= 0 && tt < T) { const bf16_t* row = Pm + (size_t)(b_ * T + tt) * NINP + col_; a_ = *(const unsigned*)row; b2_ = *(const unsigned*)(row + RW); c2_ = *(const unsigned*)(row + 2 * RW); } \
            Lp[rho] = a_; Lk[rho] = b2_; Lv[rho] = c2_; } \
        _Pragma("unroll") for (int e = 0; e < 4; ++e) { const int tte = d_ ? (ttf_ + 3 - e) : (ttf_ + e); const size_t o_ = (size_t)(b_ * T + tte) * RW + col_; \
            Lap[e] = *(const unsigned*)(LOB + (size_t)d_ * M * RW + o_); Lap1[e] = d_ ? 0u : *(const unsigned*)(LOB + (size_t)M * RW + o_); Llp[e] = *(const unsigned*)(LOUT + (size_t)d_ * M * RW + o_); } } while (0)
    if (c.vb < 2 * NB * NH * 64) PA_ISSUE(c.vb);
#if PA_CONV
    f32x4 CA[16]; cv::SubD cd;
#endif
    for (int item = c.vb; item < 2 * NB * NH * 64; item += c.nvb) {
        const int h = item & 15, ch = (item >> 4) & 63, b = (item >> 10) & 3, d = item >> 12;
        {
            const int col = h * HS + k0, pos0 = 64 * ch + 4 * tq;
            const int tt_first = d ? (T - 1 - (pos0 + 3)) : pos0;
            float rr[6][2], kr[6][2], vr[6][2];
#pragma unroll
            for (int rho = 0; rho < 6; ++rho) { const unsigned a = Lp[rho], bq = Lk[rho], cq = Lv[rho];
                rr[rho][0] = bf_lo(a); rr[rho][1] = bf_hi(a); kr[rho][0] = bf_lo(bq); kr[rho][1] = bf_hi(bq); vr[rho][0] = bf_lo(cq); vr[rho][1] = bf_hi(cq); }
            const f32x2 mr = *(const f32x2*)(mu + col), mk = *(const f32x2*)(mu + RW + col), mv = *(const f32x2*)(mu + 2 * RW + col);
            const f32x2 kkw = *(const f32x2*)(p.in[10] + col), kaw = *(const f32x2*)(p.in[11] + col);
            float re[4][2], ke[4][2], ve[4][2], as[4][2], lwv[4][2];
#pragma unroll
            for (int e = 0; e < 4; ++e) {
                const f32x2 a2 = (f32x2){bf_lo(Lap[e]), bf_hi(Lap[e])}, l2 = unpkh2(Llp[e]);
                as[e][0] = a2.x; as[e][1] = a2.y; lwv[e][0] = l2.x; lwv[e][1] = l2.y;
#pragma unroll
                for (int j = 0; j < 2; ++j) {
                    const float rc = d ? rr[4 - e][j] : rr[e + 1][j], rs = d ? (rr[3 - e][j] + rr[5 - e][j]) : (rr[e][j] + rr[e + 2][j]);
                    const float kc = d ? kr[4 - e][j] : kr[e + 1][j], ks = d ? (kr[3 - e][j] + kr[5 - e][j]) : (kr[e][j] + kr[e + 2][j]);
                    const float vc = d ? vr[4 - e][j] : vr[e + 1][j], vs = d ? (vr[3 - e][j] + vr[5 - e][j]) : (vr[e][j] + vr[e + 2][j]);
                    re[e][j] = rc + (0.5f * rs - rc) * (j ? mr.y : mr.x); ke[e][j] = kc + (0.5f * ks - kc) * (j ? mk.y : mk.x); ve[e][j] = vc + (0.5f * vs - vc) * (j ? mv.y : mv.x);
                }
            }
            if (d == 0) { const f32x2 rkw = *(const f32x2*)(p.in[12] + col); float* BON = (float*)(ws + WS_BON);
#pragma unroll
                for (int e = 0; e < 4; ++e) { const float a1x = bf_lo(Lap1[e]), a1y = bf_hi(Lap1[e]);
                    float bp = ke[e][0] * (2.0f + (as[e][0] + a1x - 2.0f) * kaw.x) * rkw.x * re[e][0] + ke[e][1] * (2.0f + (as[e][1] + a1y - 2.0f) * kaw.y) * rkw.y * re[e][1];
                    bp += __shfl_xor(bp, 1); bp += __shfl_xor(bp, 2); bp += __shfl_xor(bp, 4); bp += __shfl_xor(bp, 8); bp += __shfl_xor(bp, 16);
                    if (kp == 0) BON[(size_t)(b * T + pos0 + e) * NH + h] = bp; } }
            float kk[4][2];
#pragma unroll
            for (int e = 0; e < 4; ++e) { kk[e][0] = ke[e][0] * kkw.x; kk[e][1] = ke[e][1] * kkw.y; float n2 = kk[e][0] * kk[e][0] + kk[e][1] * kk[e][1];
                n2 += __shfl_xor(n2, 1); n2 += __shfl_xor(n2, 2); n2 += __shfl_xor(n2, 4); n2 += __shfl_xor(n2, 8); n2 += __shfl_xor(n2, 16);
                const float inv = __builtin_amdgcn_rsqf(fmaxf(n2, 1e-24f)); kk[e][0] *= inv; kk[e][1] *= inv; }
            float pre[4][2];
#pragma unroll
            for (int j = 0; j < 2; ++j) { pre[0][j] = lwv[0][j]; pre[1][j] = pre[0][j] + lwv[1][j]; pre[2][j] = pre[1][j] + lwv[2][j]; pre[3][j] = pre[2][j] + lwv[3][j]; }
            LAS float* tot = (LAS float*)(lds + L_TOT);
            *(LAS f32x2*)(tot + tq * 64 + k0) = (f32x2){pre[3][0], pre[3][1]};
            __syncthreads();
            float offs[2] = {0.f, 0.f}, lgl[2] = {0.f, 0.f};
#pragma unroll
            for (int q = 0; q < 16; ++q) { const f32x2 tv = *(const LAS f32x2*)(tot + q * 64 + k0); lgl[0] += tv.x; lgl[1] += tv.y; if (q < tq) { offs[0] += tv.x; offs[1] += tv.y; } }
            float At[4][2], Bh[4][2], Kh[4][2];
#pragma unroll
            for (int e = 0; e < 4; ++e) {
                const int tau = 4 * tq + e; float bt[2], kt[2], rt[2];
#pragma unroll
                for (int j = 0; j < 2; ++j) {
                    const float lG = offs[j] + pre[e][j], lGp = lG - lwv[e][j];
                    const float kaj = j ? kaw.y : kaw.x;
                    const float kd = ke[e][j] * (1.0f + (as[e][j] - 1.0f) * kaj), bd = kk[e][j] * as[e][j];
                    const float eg = __expf(lG), eng = __expf(-lG), elg = __expf(lgl[j] - lG);
                    At[e][j] = -kk[e][j] * __expf(lGp); bt[j] = bd * eng; kt[j] = kd * eng; rt[j] = re[e][j] * eg; Bh[e][j] = bd * elg; Kh[e][j] = kd * elg;
                }
                *(LAS unsigned*)(lds + L_AT + tau * CRS + k0 * 2) = pk2(At[e][0], At[e][1]);
                *(LAS unsigned*)(lds + L_BT + tau * CRS + k0 * 2) = pk2(bt[0], bt[1]);
                *(LAS unsigned*)(lds + L_KT + tau * CRS + k0 * 2) = pk2(kt[0], kt[1]);
                *(LAS unsigned*)(lds + L_RT + tau * CRS + k0 * 2) = pk2(rt[0], rt[1]);
            }
#pragma unroll
            for (int j = 0; j < 2; ++j) { const int x = k0 + j; const int fo = ((tq >> 2) * 4 + (x >> 4)) * 512 + ((x & 15) + 16 * (tq & 3)) * 8;
                *(LAS u32x2*)(lds + L_AF + fo) = (u32x2){pk2(At[0][j], At[1][j]), pk2(At[2][j], At[3][j])};
                *(LAS u32x2*)(lds + L_BHF + fo) = (u32x2){pk2(Bh[0][j], Bh[1][j]), pk2(Bh[2][j], Bh[3][j])};
                *(LAS u32x2*)(lds + L_KHF + fo) = (u32x2){pk2(Kh[0][j], Kh[1][j]), pk2(Kh[2][j], Kh[3][j])};
                *(LAS u32x2*)(lds + L_VF + fo) = (u32x2){pk2(ve[0][j], ve[1][j]), pk2(ve[2][j], ve[3][j])};
                if (tq == 0) ((LAS float*)(lds + L_GL))[x] = __expf(lgl[j]); }
        }
        if (item + c.nvb < 2 * NB * NH * 64) PA_ISSUE(item + c.nvb);
#if PA_CONV
        cv::sub_decode(p, lane, __builtin_amdgcn_readfirstlane(item * NWAVES + w), cd);
#pragma unroll
        for (int i = 0; i < 16; ++i) CA[i] = __builtin_nontemporal_load(cd.src + (size_t)i * cd.rs4);
#endif
        __syncthreads();
#pragma unroll 1
        for (int tix = w; tix < 40; tix += 8) {
            const int pidx = tix >> 2, mat = tix & 3;
            const int i = pidx < 1 ? 0 : (pidx < 3 ? 1 : (pidx < 6 ? 2 : 3)), j = pidx - (i * (i + 1)) / 2;
            const int abase = (mat < 2 ? L_AT : L_RT) + (16 * i + m16) * CRS + 16 * g, bbase = ((mat & 1) ? L_KT : L_BT) + (16 * j + m16) * CRS + 16 * g;
            f32x4 acc = (f32x4){0.f, 0.f, 0.f, 0.f};
            acc = mfma32(*(const LAS bf16x8*)(lds + abase), *(const LAS bf16x8*)(lds + bbase), acc);
            acc = mfma32(*(const LAS bf16x8*)(lds + abase + 64), *(const LAS bf16x8*)(lds + bbase + 64), acc);
            const int tcol = 16 * j + m16; LAS unsigned char* mo = lds + L_MAB + mat * 9216 + tcol * 2;
#pragma unroll
            for (int jj = 0; jj < 4; ++jj) { const int trow = 16 * i + 4 * g + jj; const bool keep = (mat < 2) ? (tcol < trow) : (tcol <= trow);
                *(LAS unsigned short*)(mo + trow * CRS) = (unsigned short)f2bf(keep ? acc[jj] : 0.f); }
        }
        __syncthreads();
        if (w == 0) {
            const int blk = g, cc = m16; float t[16];
#pragma unroll
            for (int r = 0; r < 16; ++r) {
                const LAS unsigned char* rowp = lds + L_MAB + (16 * blk + r) * CRS + 32 * blk; float a[16];
                unpack8(*(const LAS u32x4*)rowp, a); unpack8(*(const LAS u32x4*)(rowp + 16), a + 8);
                float s = (r == cc) ? 1.0f : 0.0f;
#pragma unroll
                for (int q = 0; q < r; ++q) s += a[q] * t[q];
                t[r] = s;
                *(LAS unsigned short*)(lds + L_MTI + (16 * blk + r) * 48 + cc * 2) = (unsigned short)f2bf(s);
            }
        }
        __syncthreads();
        {
            const bool right = w >= 4; const int cb = w & 3;
#define LDM(base, row, cblk) (*(const LAS bf16x4*)(lds + (base) + (row) * CRS + (cblk) * 32 + 8 * g))
#define LDF(base, tile) (*(const LAS bf16x4*)(lds + (base) + (tile) * 512 + lane * 8))
#define LDTI(row) (*(const LAS bf16x4*)(lds + L_MTI + (row) * 48 + 8 * g))
            bf16x4 XB[4];
#pragma unroll
            for (int i = 0; i < 4; ++i) {
                f32x4 Z;
                if (!right) Z = unpack4(LDF(L_AF, i * 4 + cb));
                else { Z = (f32x4){0.f, 0.f, 0.f, 0.f};
                    if (i == 0) Z = mfma32(cat8(LDM(L_MAK, m16, 0), zero4), cat8(LDF(L_VF, cb), zero4), Z);
                    if (i == 1) Z = mfma32(cat8(LDM(L_MAK, 16 + m16, 0), LDM(L_MAK, 16 + m16, 1)), cat8(LDF(L_VF, cb), LDF(L_VF, 4 + cb)), Z);
                    if (i == 2) { Z = mfma32(cat8(LDM(L_MAK, 32 + m16, 0), LDM(L_MAK, 32 + m16, 1)), cat8(LDF(L_VF, cb), LDF(L_VF, 4 + cb)), Z);
                                  Z = mfma32(cat8(LDM(L_MAK, 32 + m16, 2), zero4), cat8(LDF(L_VF, 8 + cb), zero4), Z); }
                    if (i == 3) { Z = mfma32(cat8(LDM(L_MAK, 48 + m16, 0), LDM(L_MAK, 48 + m16, 1)), cat8(LDF(L_VF, cb), LDF(L_VF, 4 + cb)), Z);
                                  Z = mfma32(cat8(LDM(L_MAK, 48 + m16, 2), LDM(L_MAK, 48 + m16, 3)), cat8(LDF(L_VF, 8 + cb), LDF(L_VF, 12 + cb)), Z); } }
                if (i == 1) Z = mfma32(cat8(LDM(L_MAB, 16 + m16, 0), zero4), cat8(XB[0], zero4), Z);
                if (i == 2) Z = mfma32(cat8(LDM(L_MAB, 32 + m16, 0), LDM(L_MAB, 32 + m16, 1)), cat8(XB[0], XB[1]), Z);
                if (i == 3) { Z = mfma32(cat8(LDM(L_MAB, 48 + m16, 0), LDM(L_MAB, 48 + m16, 1)), cat8(XB[0], XB[1]), Z);
                              Z = mfma32(cat8(LDM(L_MAB, 48 + m16, 2), zero4), cat8(XB[2], zero4), Z); }
                const f32x4 X = mfma32(cat8(LDTI(16 * i + m16), zero4), cat8(pack4(Z), zero4), (f32x4){0.f, 0.f, 0.f, 0.f});
                XB[i] = pack4(X);
            }
            unsigned char* fbase = ws + (size_t)((item & ~1023) | (h << 6) | ch) * 8192 + lane * 8;
            if (!right) {
                const LAS float* gl = (const LAS float*)(lds + L_GL);
#pragma unroll
                for (int kpb = 0; kpb < 4; ++kpb) {
                    f32x4 Dm = (f32x4){0.f, 0.f, 0.f, 0.f};
                    Dm = mfma32(cat8(XB[0], XB[1]), cat8(LDF(L_BHF, kpb), LDF(L_BHF, 4 + kpb)), Dm);
                    Dm = mfma32(cat8(XB[2], XB[3]), cat8(LDF(L_BHF, 8 + kpb), LDF(L_BHF, 12 + kpb)), Dm);
                    if (kpb == cb) { const float gv = gl[16 * cb + m16];
#pragma unroll
                        for (int jj = 0; jj < 4; ++jj) if (4 * g + jj == m16) Dm[jj] += gv; }
                    *(bf16x4*)(fbase + WS_MF + (kpb * 4 + cb) * 512) = pack4(Dm);
                }
#pragma unroll
                for (int i = 0; i < 4; ++i) {
                    f32x4 Dq = unpack4(*(const LAS bf16x4*)(lds + L_RT + (16 * i + m16) * CRS + cb * 32 + 8 * g));
                    if (i == 0) Dq = mfma32(cat8(XB[0], zero4), cat8(LDM(L_MRB, m16, 0), zero4), Dq);
                    if (i >= 1) Dq = mfma32(cat8(XB[0], XB[1]), cat8(LDM(L_MRB, 16 * i + m16, 0), LDM(L_MRB, 16 * i + m16, 1)), Dq);
                    if (i == 2) Dq = mfma32(cat8(XB[2], zero4), cat8(LDM(L_MRB, 32 + m16, 2), zero4), Dq);
                    if (i == 3) Dq = mfma32(cat8(XB[2], XB[3]), cat8(LDM(L_MRB, 48 + m16, 2), LDM(L_MRB, 48 + m16, 3)), Dq);
                    *(bf16x4*)(fbase + WS_QF + (i * 4 + cb) * 512) = pack4(Dq);
                }
            } else {
#pragma unroll
                for (int kpb = 0; kpb < 4; ++kpb) {
                    f32x4 Dn = (f32x4){0.f, 0.f, 0.f, 0.f};
                    Dn = mfma32(cat8(LDF(L_BHF, kpb), LDF(L_BHF, 4 + kpb)), cat8(XB[0], XB[1]), Dn);
                    Dn = mfma32(cat8(LDF(L_BHF, 8 + kpb), LDF(L_BHF, 12 + kpb)), cat8(XB[2], XB[3]), Dn);
                    Dn = mfma32(cat8(LDF(L_KHF, kpb), LDF(L_KHF, 4 + kpb)), cat8(LDF(L_VF, cb), LDF(L_VF, 4 + cb)), Dn);
                    Dn = mfma32(cat8(LDF(L_KHF, 8 + kpb), LDF(L_KHF, 12 + kpb)), cat8(LDF(L_VF, 8 + cb), LDF(L_VF, 12 + cb)), Dn);
                    *(bf16x4*)(fbase + WS_NF + (kpb * 4 + cb) * 512) = pack4(Dn);
                }
#pragma unroll
                for (int i = 0; i < 4; ++i) {
                    f32x4 Dy = (f32x4){0.f, 0.f, 0.f, 0.f};
                    if (i == 0) { Dy = mfma32(cat8(LDM(L_MRB, m16, 0), zero4), cat8(XB[0], zero4), Dy);
                                  Dy = mfma32(cat8(LDM(L_MRK, m16, 0), zero4), cat8(LDF(L_VF, cb), zero4), Dy); }
                    if (i >= 1) { Dy = mfma32(cat8(LDM(L_MRB, 16 * i + m16, 0), LDM(L_MRB, 16 * i + m16, 1)), cat8(XB[0], XB[1]), Dy);
                                  Dy = mfma32(cat8(LDM(L_MRK, 16 * i + m16, 0), LDM(L_MRK, 16 * i + m16, 1)), cat8(LDF(L_VF, cb), LDF(L_VF, 4 + cb)), Dy); }
                    if (i == 2) { Dy = mfma32(cat8(LDM(L_MRB, 32 + m16, 2), zero4), cat8(XB[2], zero4), Dy);
                                  Dy = mfma32(cat8(LDM(L_MRK, 32 + m16, 2), zero4), cat8(LDF(L_VF, 8 + cb), zero4), Dy); }
                    if (i == 3) { Dy = mfma32(cat8(LDM(L_MRB, 48 + m16, 2), LDM(L_MRB, 48 + m16, 3)), cat8(XB[2], XB[3]), Dy);
                                  Dy = mfma32(cat8(LDM(L_MRK, 48 + m16, 2), LDM(L_MRK, 48 + m16, 3)), cat8(LDF(L_VF, 8 + cb), LDF(L_VF, 12 + cb)), Dy); }
                    *(bf16x4*)(fbase + WS_Y0F + (i * 4 + cb) * 512) = pack4(Dy);
                }
            }
#undef LDM
#undef LDF
#undef LDTI
        }
#if PA_CONV
#pragma unroll
        for (int ee = 0; ee < 4; ++ee) { u32x4 o;
#pragma unroll
            for (int qd = 0; qd < 4; ++qd) o[qd] = pk4_fp8w(CA[4 * qd][ee] * FP8_MUL_W, CA[4 * qd + 1][ee] * FP8_MUL_W, CA[4 * qd + 2][ee] * FP8_MUL_W, CA[4 * qd + 3][ee] * FP8_MUL_W);
            *(u32x4*)(cd.dst + (size_t)ee * D) = o; }
#endif
        __syncthreads();
    }
#undef PA_ISSUE
}

__device__ __forceinline__ void ph_chunk_state(const Prm& p, const Ctx& c) {
    unsigned char* ws = p.ws; const int lane = c.lane;
    if (c.wave < 2) for (int wi = c.vb * 2 + c.wave; wi < 2 * NB * NH * 4; wi += c.nvb * 2) {
        const int seq = wi >> 2, vb = wi & 3;
        f32x4 ST[4];
#pragma unroll
        for (int kb = 0; kb < 4; ++kb) ST[kb] = (f32x4){0.f, 0.f, 0.f, 0.f};
        bf16x4 mf[3][16], nf[3][4];
#define PB_LOAD(buf, ch_) do { const int chc_ = (ch_) < 64 ? (ch_) : 63; const unsigned char* ib_ = ws + (size_t)(seq * 64 + chc_) * 8192 + lane * 8; \
            _Pragma("unroll") for (int q = 0; q < 16; ++q) mf[buf][q] = *(const bf16x4*)(ib_ + WS_MF + q * 512); \
            _Pragma("unroll") for (int q = 0; q < 4; ++q) nf[buf][q] = *(const bf16x4*)(ib_ + WS_NF + (q * 4 + vb) * 512); } while (0)
#define PB_STEP(buf, ch_) do { if ((ch_) < 64) { unsigned char* ob_ = ws + (size_t)(seq * 64 + (ch_)) * 8192 + lane * 8 + WS_SF; bf16x4 SB[4]; \
            _Pragma("unroll") for (int kb = 0; kb < 4; ++kb) { SB[kb] = pack4(ST[kb]); *(bf16x4*)(ob_ + (kb * 4 + vb) * 512) = SB[kb]; } \
            _Pragma("unroll") for (int kpb = 0; kpb < 4; ++kpb) { f32x4 Dn = unpack4(nf[buf][kpb]); \
                Dn = mfma32(cat8(mf[buf][kpb * 4 + 0], mf[buf][kpb * 4 + 1]), cat8(SB[0], SB[1]), Dn); \
                Dn = mfma32(cat8(mf[buf][kpb * 4 + 2], mf[buf][kpb * 4 + 3]), cat8(SB[2], SB[3]), Dn); ST[kpb] = Dn; } } } while (0)
        PB_LOAD(0, 0); PB_LOAD(1, 1);
#pragma unroll 1
        for (int ch = 0; ch < 64; ch += 3) {
            PB_LOAD(2, ch + 2); PB_STEP(0, ch);
            PB_LOAD(0, ch + 3); PB_STEP(1, ch + 1);
            PB_LOAD(1, ch + 4); PB_STEP(2, ch + 2);
        }
#undef PB_LOAD
#undef PB_STEP
    }
}

constexpr int YL_RS = 68;
__device__ __forceinline__ void ld8f(const float* p8, float* o) { const f32x4 t0 = *(const f32x4*)p8, t1 = *(const f32x4*)(p8 + 4); o[0] = t0.x; o[1] = t0.y; o[2] = t0.z; o[3] = t0.w; o[4] = t1.x; o[5] = t1.y; o[6] = t1.z; o[7] = t1.w; }
__device__ __forceinline__ void ph_chunk_out(const Prm& p, const Ctx& c) {
    unsigned char* ws = p.ws; const bf16_t* Pm = (const bf16_t*)(ws + WS_P); const float* mu = p.in[4]; const bf16_t* LOB = (const bf16_t*)(ws + WS_LOB); bf16_t* MIX = (bf16_t*)(ws + WS_MIX);
    LAS float* YL = (LAS float*)c.lds;
    const int lane = c.lane, m16 = lane & 15, g = lane >> 4, w = c.wave;
    const int d = w >> 2, i = w & 3;
    bf16x4 qf[4], y0f[4], sf[4][4];
#define PC_LOADFR(item_) do { const int h_ = (item_) & 15, n_ = ((item_) >> 4) & 63, b_ = (item_) >> 10; const int it_ = ((d * NB + b_) * NH + h_) * 64 + (d ? 63 - n_ : n_); \
        const unsigned char* ib_ = ws + (size_t)it_ * 8192 + lane * 8; \
        _Pragma("unroll") for (int kb = 0; kb < 4; ++kb) qf[kb] = *(const bf16x4*)(ib_ + WS_QF + (i * 4 + kb) * 512); \
        _Pragma("unroll") for (int vb = 0; vb < 4; ++vb) { y0f[vb] = *(const bf16x4*)(ib_ + WS_Y0F + (i * 4 + vb) * 512); \
            _Pragma("unroll") for (int kb = 0; kb < 4; ++kb) sf[kb][vb] = *(const bf16x4*)(ib_ + WS_SF + (kb * 4 + vb) * 512); } } while (0)
    if (c.vb < NB * NH * 64) PC_LOADFR(c.vb);
    for (int item = c.vb; item < NB * NH * 64; item += c.nvb) {
        const int h = item & 15, n = (item >> 4) & 63, b = item >> 10;
        const int rho = c.tid >> 3, cg = c.tid & 7, c8 = 8 * cg, tt = 64 * n + rho, tok = b * T + tt, col = h * HS + c8;
        const bool hp = tt > 0, hn = tt < T - 1;
        const u32x4 z4 = (u32x4){0u, 0u, 0u, 0u};
        bf16_t* mrow = MIX + (size_t)tok * D + col;
        float v[8], bon, lw8[8], lb8[8], g8[8];
        { const bf16_t* row = Pm + (size_t)tok * NINP + col;
          float a[8], pm[8], pn[8], mm[8];
          unpack8(*(const u32x4*)(row + 2 * RW), a); unpack8(hp ? *(const u32x4*)(row + 2 * RW - NINP) : z4, pm); unpack8(hn ? *(const u32x4*)(row + 2 * RW + NINP) : z4, pn); ld8f(mu + 2 * RW + col, mm);
#pragma unroll
          for (int q = 0; q < 8; ++q) v[q] = zshift(a[q], pm[q], pn[q], mm[q]);
          bon = ((const float*)(ws + WS_BON))[(size_t)tok * NH + h];
          ld8f(p.in[13] + col, lw8); ld8f(p.in[14] + col, lb8); unpack8(*(const u32x4*)(LOB + ((size_t)2 * M + tok) * RW + col), g8);
          const bf16_t* crow = Pm + (size_t)tok * NINP + NRC + col;
          float gb[8], gc[8], uu[8], cu0[8], cu1[8], cu2[8], o[8];
          unpack8(*(const u32x4*)crow, gb);
          unpack8(*(const u32x4*)(crow + CWD), gc); unpack8(*(const u32x4*)(crow + 2 * CWD), uu);
#pragma unroll
          for (int q = 0; q < 8; ++q) cu1[q] = gc[q] * uu[q];
          unpack8(hp ? *(const u32x4*)(crow + CWD - NINP) : z4, gc); unpack8(hp ? *(const u32x4*)(crow + 2 * CWD - NINP) : z4, uu);
#pragma unroll
          for (int q = 0; q < 8; ++q) cu0[q] = gc[q] * uu[q];
          unpack8(hn ? *(const u32x4*)(crow + CWD + NINP) : z4, gc); unpack8(hn ? *(const u32x4*)(crow + 2 * CWD + NINP) : z4, uu);
#pragma unroll
          for (int q = 0; q < 8; ++q) cu2[q] = gc[q] * uu[q];
          float w0[8], w1[8], w2[8]; ld8f(p.in[15] + col, w0); ld8f(p.in[15] + CWD + col, w1); ld8f(p.in[15] + 2 * CWD + col, w2);
#pragma unroll
          for (int q = 0; q < 8; ++q) o[q] = gb[q] * (w0[q] * cu0[q] + w1[q] * cu1[q] + w2[q] * cu2[q]);
          *(u32x4*)(mrow + RW) = (u32x4){pk2(o[0], o[1]), pk2(o[2], o[3]), pk2(o[4], o[5]), pk2(o[6], o[7])};
        }
#pragma unroll
        for (int vb = 0; vb < 4; ++vb) {
            f32x4 Dy = unpack4(y0f[vb]);
            Dy = mfma32(cat8(qf[0], qf[1]), cat8(sf[0][vb], sf[1][vb]), Dy);
            Dy = mfma32(cat8(qf[2], qf[3]), cat8(sf[2][vb], sf[3][vb]), Dy);
#pragma unroll
            for (int jj = 0; jj < 4; ++jj) { const int tau = 16 * i + 4 * g + jj, rr = d ? 63 - tau : tau; YL[(d * 64 + rr) * YL_RS + 16 * vb + m16] = Dy[jj]; }
        }
        if (item + c.nvb < NB * NH * 64) PC_LOADFR(item + c.nvb);
        __syncthreads();
        { float y[8];
          { const LAS float* y0 = YL + rho * YL_RS + c8; const LAS float* y1 = YL + (64 + rho) * YL_RS + c8;
#pragma unroll
            for (int q = 0; q < 8; ++q) y[q] = y0[q] + y1[q]; }
          float s1 = 0.f;
#pragma unroll
          for (int q = 0; q < 8; ++q) s1 += y[q];
          s1 += __shfl_xor(s1, 1); s1 += __shfl_xor(s1, 2); s1 += __shfl_xor(s1, 4);
          const float mean = s1 * (1.0f / 64.0f); float qv = 0.f;
#pragma unroll
          for (int q = 0; q < 8; ++q) { y[q] -= mean; qv += y[q] * y[q]; }
          qv += __shfl_xor(qv, 1); qv += __shfl_xor(qv, 2); qv += __shfl_xor(qv, 4);
          const float rstd = __builtin_amdgcn_rsqf(qv * (1.0f / 64.0f) + LNX_EPS);
          float o[8];
#pragma unroll
          for (int q = 0; q < 8; ++q) o[q] = (y[q] * rstd * lw8[q] + lb8[q] + bon * v[q]) * g8[q];
          *(u32x4*)mrow = (u32x4){pk2(o[0], o[1]), pk2(o[2], o[3]), pk2(o[4], o[5]), pk2(o[6], o[7])}; }
        __syncthreads();
    }
#undef PC_LOADFR
}

__device__ __forceinline__ void ph_gemm_out(const Prm& p, const Ctx& c) {
    unsigned char* ws = p.ws;
    ProbRes P{(const bf16_t*)(ws + WS_MIX), (const bf16_t*)(ws + WS_WOUT), p.in[0], (bf16_t*)(ws + WS_X1), D};
    pg8::Order S; S.init(M / 256, D / 256, c.nvb, c.vb, nullptr);
    { int m1, s_, c_; cv::slot_split(c.nvb, c.vb, m1, s_, c_); gemm_with_slot<ProbRes>(p, c, P, S, (M / 256) * (D / 256), (c.vb >> 3) % 3, m1 + c.nvb * NWAVES * CW3, CW7); }
}

constexpr int RT_GT = 8, RT_NG = M / RT_GT;
constexpr int RL_PART = 0, RL_SS = 65536, RL_LG = 67584, RL_RSTD = 75776;
__device__ __forceinline__ void ph_route(const Prm& p, const Ctx& c) {
    unsigned char* ws = p.ws; const bf16_t* X1 = (const bf16_t*)(ws + WS_X1); const bf16_t* RWT = (const bf16_t*)(ws + WS_RWT); const float* g = p.in[17]; const float* rb = p.in[19];
    bf16_t* H2 = (bf16_t*)(ws + WS_H2); int* SELE = (int*)(ws + WS_SELE); int* SELR = (int*)(ws + WS_SELR); float* SELG = (float*)(ws + WS_SELG); unsigned* HIST = (unsigned*)(ws + WS_HIST);
    LAS unsigned char* lds = c.lds;
    const int lane = c.lane, m16 = lane & 15, g4 = lane >> 4, w = c.wave;
    for (int blk = c.vb; blk < M / 64; blk += c.nvb) {
        const int tok0 = blk * 64, kw = 256 * w + 8 * g4;
        f32x4 acc[4][2]; float ssp[4] = {0.f, 0.f, 0.f, 0.f};
#pragma unroll
        for (int t = 0; t < 4; ++t) { acc[t][0] = (f32x4){0.f, 0.f, 0.f, 0.f}; acc[t][1] = (f32x4){0.f, 0.f, 0.f, 0.f}; }
#pragma unroll 1
        for (int sh = 0; sh < 4; ++sh) {
            bf16x8 xa[4][2];
#pragma unroll
            for (int t = 0; t < 4; ++t)
#pragma unroll
                for (int s4 = 0; s4 < 2; ++s4) xa[t][s4] = *(const bf16x8*)(X1 + (size_t)(tok0 + 16 * t + m16) * D + kw + 32 * (2 * sh + s4));
#pragma unroll
            for (int s4 = 0; s4 < 2; ++s4) {
                bf16x8 bw[2][3];
#pragma unroll
                for (int et = 0; et < 2; ++et)
#pragma unroll
                    for (int part = 0; part < 3; ++part) bw[et][part] = *(const bf16x8*)(RWT + (size_t)(part * NE + 16 * et + m16) * D + kw + 32 * (2 * sh + s4));
#pragma unroll
                for (int t = 0; t < 4; ++t) {
                    { const u32x4 xw = __builtin_bit_cast(u32x4, xa[t][s4]); float xv[8]; unpack8(xw, xv);
#pragma unroll
                      for (int q = 0; q < 8; ++q) ssp[t] += xv[q] * xv[q]; }
#pragma unroll
                    for (int et = 0; et < 2; ++et)
#pragma unroll
                        for (int part = 2; part >= 0; --part) acc[t][et] = mfma32(xa[t][s4], bw[et][part], acc[t][et]);
                }
            }
        }
#pragma unroll
        for (int t = 0; t < 4; ++t) { float v = ssp[t]; v += __shfl_xor(v, 16); v += __shfl_xor(v, 32); if (g4 == 0) ((LAS float*)(lds + RL_SS))[w * 64 + 16 * t + m16] = v;
            *(LAS f32x4*)(lds + RL_PART + ((w * 8 + t * 2 + 0) * 64 + lane) * 16) = acc[t][0]; *(LAS f32x4*)(lds + RL_PART + ((w * 8 + t * 2 + 1) * 64 + lane) * 16) = acc[t][1]; }
        __syncthreads();
        { const int tile = c.tid >> 6, ln = c.tid & 63; f32x4 v = (f32x4){0.f, 0.f, 0.f, 0.f};
#pragma unroll
          for (int ww = 0; ww < 8; ++ww) v += *(const LAS f32x4*)(lds + RL_PART + ((ww * 8 + tile) * 64 + ln) * 16);
          const int tk = 16 * (tile >> 1) + 4 * (ln >> 4), ex = 16 * (tile & 1) + (ln & 15);
#pragma unroll
          for (int r = 0; r < 4; ++r) ((LAS float*)(lds + RL_LG))[(tk + r) * NE + ex] = v[r];
          if (c.tid < 64) { float ss = 0.f;
#pragma unroll
              for (int ww = 0; ww < 8; ++ww) ss += ((const LAS float*)(lds + RL_SS))[ww * 64 + c.tid];
              ((LAS float*)(lds + RL_RSTD))[c.tid] = 1.0f / sqrtf(ss * (1.0f / D) + RMS_EPS); } }
        __syncthreads();
        unsigned mycnt = 0; const int grp = blk * 8 + w;
        u32x2 xnx[8];
        { const u32x2* x4 = (const u32x2*)(X1 + (size_t)(tok0 + 8 * w) * D) + lane;
#pragma unroll
          for (int j = 0; j < 8; ++j) xnx[j] = x4[64 * j]; }
#pragma unroll 1
        for (int q = 0; q < 8; ++q) {
            const int tl = 8 * w + q, tok = tok0 + tl;
            u32x2 xcur[8];
#pragma unroll
            for (int j = 0; j < 8; ++j) xcur[j] = xnx[j];
            { const u32x2* x4 = (const u32x2*)(X1 + (size_t)(tok + (q < 7 ? 1 : 0)) * D) + lane;
#pragma unroll
              for (int j = 0; j < 8; ++j) xnx[j] = x4[64 * j]; }
            const float rstd = ((const LAS float*)(lds + RL_RSTD))[tl];
            float lg[NE];
#pragma unroll
            for (int e4 = 0; e4 < NE / 4; ++e4) { const f32x4 v = *(const LAS f32x4*)(lds + RL_LG + (tl * NE + 4 * e4) * 4); const f32x4 bb = *(const f32x4*)(rb + 4 * e4);
                lg[4 * e4] = v.x * rstd + bb.x; lg[4 * e4 + 1] = v.y * rstd + bb.y; lg[4 * e4 + 2] = v.z * rstd + bb.z; lg[4 * e4 + 3] = v.w * rstd + bb.w; }
            { unsigned* o4 = (unsigned*)((unsigned char*)H2 + (size_t)tok * D) + lane; const float rs = rstd * FP8_MUL_X;
#pragma unroll
              for (int j = 0; j < 8; ++j) { const u32x2 xw = xcur[j]; const f32x4 v = (f32x4){bf_lo(xw.x), bf_hi(xw.x), bf_lo(xw.y), bf_hi(xw.y)}, gg = ((const f32x4*)g)[lane + 64 * j];
                  o4[64 * j] = pk4_fp8(v.x * rs * gg.x, v.y * rs * gg.y, v.z * rs * gg.z, v.w * rs * gg.w); } }
            int se[4]; float sv[4];
#pragma unroll
            for (int kk = 0; kk < 4; ++kk) { float best = -3.0e38f; int bi = 0;
#pragma unroll
                for (int e = 0; e < NE; ++e) { const bool taken = (kk > 0 && se[0] == e) || (kk > 1 && se[1] == e) || (kk > 2 && se[2] == e); if (!taken && lg[e] > best) { best = lg[e]; bi = e; } }
                se[kk] = bi; sv[kk] = best; }
            const float e1 = __expf(sv[1] - sv[0]), e2 = __expf(sv[2] - sv[0]), e3 = __expf(sv[3] - sv[0]); const float inv = 1.0f / (1.0f + e1 + e2 + e3);
            const float gt[4] = {inv, e1 * inv, e2 * inv, e3 * inv};
#pragma unroll
            for (int kk = 0; kk < 4; ++kk) {
                const int ee = __builtin_amdgcn_readfirstlane(se[kk]);
                const unsigned rk = (unsigned)__builtin_amdgcn_readlane((int)mycnt, ee);
                if (lane == ee) ++mycnt;
                if (lane == kk) { SELE[tok * 4 + kk] = ee; SELR[tok * 4 + kk] = (int)rk; SELG[tok * 4 + kk] = gt[kk]; }
            }
        }
        if (lane < NE) HIST[(size_t)grp * NE + lane] = mycnt;
        __syncthreads();
    }
}

__device__ __forceinline__ void build_expert_table(const Prm& p, const Ctx& c) {
    LAS int* tab = (LAS int*)(c.lds + LDS_TAB); const unsigned* cnt = (const unsigned*)(p.ws + WS_CTL) + CW_CNT;
    if (c.tid < NE) tab[32 + c.tid] = (int)__hip_atomic_load(cnt + c.tid, __ATOMIC_RELAXED, __HIP_MEMORY_SCOPE_AGENT);
    __syncthreads();
    if (c.tid == 0) { int mt = 0;
        for (int e = 0; e < NE; ++e) { const int n = tab[32 + e], nt = (n + 255) >> 8; tab[e] = mt * 256;
            for (int j = 0; j < nt && mt + j < MAXMT; ++j) tab[128 + mt + j] = e; mt += nt; }
        tab[64] = mt < MAXMT ? mt : MAXMT; }
    __syncthreads();
}

__device__ __forceinline__ void ph_place(const Prm& p, const Ctx& c) {
    unsigned char* ws = p.ws;
    LAS int* tab = (LAS int*)(c.lds + LDS_TAB); LAS unsigned* red = (LAS unsigned*)c.lds;
    const unsigned* HIST = (const unsigned*)(ws + WS_HIST);
    const int gw0 = c.vb * NWAVES;
    { const int e = c.tid & 31, part = c.tid >> 5; unsigned tot = 0, pre = 0;
#pragma unroll 1
      for (int g0 = 0; g0 < RT_NG; g0 += 16 * 32) { unsigned hv[32];
#pragma unroll
          for (int i = 0; i < 32; ++i) hv[i] = HIST[(size_t)(g0 + part + 16 * i) * NE + e];
#pragma unroll
          for (int i = 0; i < 32; ++i) { tot += hv[i]; if (g0 + part + 16 * i < gw0) pre += hv[i]; } }
      red[part * 64 + e] = tot; red[part * 64 + 32 + e] = pre; }
    __syncthreads();
    if (c.tid < 64) { unsigned s = 0;
#pragma unroll
        for (int q = 0; q < 16; ++q) s += red[q * 64 + c.tid];
        tab[512 + c.tid] = (int)s; }
    __syncthreads();
    if (c.tid == 0) { int mt = 0;
        for (int e = 0; e < NE; ++e) { const int n = tab[512 + e], nt = (n + 255) >> 8; tab[e] = mt * 256; tab[32 + e] = n;
            for (int j = 0; j < nt && mt + j < MAXMT; ++j) tab[128 + mt + j] = e; mt += nt; }
        tab[64] = mt < MAXMT ? mt : MAXMT; }
    if (c.vb == 0 && c.tid < NE) __hip_atomic_store((unsigned*)(ws + WS_CTL) + CW_CNT + c.tid, (unsigned)tab[512 + c.tid], __ATOMIC_RELAXED, __HIP_MEMORY_SCOPE_AGENT);
    __syncthreads();
    int* ROWTOK = (int*)(ws + WS_XG); float* RG = (float*)(ws + WS_RGATE);
    const int* SELE = (const int*)(ws + WS_SELE); const int* SELR = (const int*)(ws + WS_SELR); const float* SELG = (const float*)(ws + WS_SELG); int* DEST = (int*)(ws + WS_DEST);
    const int gw = c.vb * NWAVES + c.wave, NGW = c.nvb * NWAVES;
    for (int grp = gw; grp < RT_NG; grp += NGW) {
        unsigned base = 0;
        if (c.lane < NE) { if (grp < gw0 + NWAVES) { base = (unsigned)tab[544 + c.lane]; for (int gq = gw0; gq < grp; ++gq) base += HIST[(size_t)gq * NE + c.lane]; }
                           else { for (int gq = 0; gq < grp; ++gq) base += HIST[(size_t)gq * NE + c.lane]; } }
        { const int a = grp * RT_GT * TOPK + (c.lane & 31), tok = a >> 2;
          const int e = SELE[a]; const unsigned be = (unsigned)__shfl((int)base, e);
          const int dest = tab[e] + (int)be + SELR[a];
          if (c.lane < RT_GT * TOPK) { ROWTOK[dest] = tok; RG[dest] = SELG[a]; DEST[a] = dest; } }
    }
    for (int it = gw; it < NE * 256; it += NGW) {
        const int e = it >> 8, j = it & 255, n = tab[32 + e], rem = n & 255;
        if (rem != 0 && j >= rem) { const int dest = tab[e] + (n & ~255) + j; if (c.lane == 0) { ROWTOK[dest] = 0; RG[dest] = 0.f; } }
    }
}

__device__ __forceinline__ void ph_gemm_gu(const Prm& p, const Ctx& c) {
    unsigned char* ws = p.ws; build_expert_table(p, c); const LAS int* tab = (const LAS int*)(c.lds + LDS_TAB);
    ProbGU P{(const bf16_t*)(ws + WS_H2), (const bf16_t*)(ws + WS_WGU), (bf16_t*)(ws + WS_ACT), p.in[21], D / 2};
    pg8::Order S; S.init(__builtin_amdgcn_readfirstlane(tab[64]), DFF / 128, c.nvb, c.vb, tab + 128);
    LAS unsigned* rowtab = (LAS unsigned*)(c.lds + LDS_ROWT); const int* ROWTOK = (const int*)(ws + WS_XG);
    { unsigned rv[ROWT_UNITS];
#pragma unroll
      for (int i = 0; i < ROWT_UNITS; ++i) { pg8::Unit u; const bool ok = S.next(i, u); rv[i] = (ok && c.tid < 256) ? (unsigned)ROWTOK[u.pm * 256 + c.tid] : 0u; }
#pragma unroll
      for (int i = 0; i < ROWT_UNITS; ++i) if (c.tid < 256) rowtab[i * 256 + c.tid] = rv[i] * (unsigned)D; }
    __syncthreads();
    pg8::gemm_phase<ProbGU, true, true, true>(c.lds, P, S, rowtab);
}
__device__ __forceinline__ void ph_gemm_dn(const Prm& p, const Ctx& c) {
    unsigned char* ws = p.ws; build_expert_table(p, c); const LAS int* tab = (const LAS int*)(c.lds + LDS_TAB);
    ProbDN P{(const bf16_t*)(ws + WS_ACT), (const bf16_t*)(ws + WS_WDN), (bf16_t*)(ws + WS_YB), p.in[23], (const float*)(ws + WS_RGATE), DFF / 2};
    pg8::Order S; S.init(__builtin_amdgcn_readfirstlane(tab[64]), D / 256, c.nvb, c.vb, tab + 128); pg8::gemm_phase<ProbDN, true, true>(c.lds, P, S);
}

__device__ __forceinline__ void ph_combine(const Prm& p, const Ctx& c) {
    unsigned char* ws = p.ws; const bf16_t* X1 = (const bf16_t*)(ws + WS_X1); const bf16_t* YB = (const bf16_t*)(ws + WS_YB); const int* DEST = (const int*)(ws + WS_DEST);
    bf16_t* X2 = (bf16_t*)(ws + WS_X2); bf16_t* HP = (bf16_t*)(ws + WS_HP); const float* g = p.in[24];
    const int gw = c.vb * NWAVES + c.wave, NGW = c.nvb * NWAVES;
    for (int tok0 = gw; tok0 < M; tok0 += 2 * NGW) {
        int tk[2]; tk[0] = tok0; tk[1] = tok0 + NGW < M ? tok0 + NGW : tok0; const bool two = tok0 + NGW < M;
        int dst[2][4];
#pragma unroll
        for (int t = 0; t < 2; ++t)
#pragma unroll
            for (int kk = 0; kk < 4; ++kk) dst[t][kk] = DEST[tk[t] * 4 + kk];
        u32x2 xw[2][8]; unsigned yw[2][4][8];
#pragma unroll
        for (int t = 0; t < 2; ++t) { const u32x2* xr = (const u32x2*)(X1 + (size_t)tk[t] * D) + c.lane;
#pragma unroll
            for (int j = 0; j < 8; ++j) xw[t][j] = xr[64 * j]; }
#pragma unroll
        for (int t = 0; t < 2; ++t)
#pragma unroll
            for (int kk = 0; kk < 4; ++kk) { const unsigned* yr = (const unsigned*)((const unsigned char*)YB + (size_t)dst[t][kk] * D) + c.lane;
#pragma unroll
                for (int j = 0; j < 8; ++j) yw[t][kk][j] = yr[64 * j]; }
#pragma unroll
        for (int t = 0; t < 2; ++t) { if (t == 1 && !two) break;
            const int tok = tk[t]; f32x4 v[8];
#pragma unroll
            for (int j = 0; j < 8; ++j) { v[j] = (f32x4){bf_lo(xw[t][j].x), bf_hi(xw[t][j].x), bf_lo(xw[t][j].y), bf_hi(xw[t][j].y)};
#pragma unroll
                for (int kk = 0; kk < 4; ++kk) { const unsigned w = yw[t][kk][j]; const f32x2 lo = __builtin_amdgcn_cvt_pk_f32_fp8(w, false), hi = __builtin_amdgcn_cvt_pk_f32_fp8(w, true);
                    v[j].x += lo.x * (1.0f / YB_MUL); v[j].y += lo.y * (1.0f / YB_MUL); v[j].z += hi.x * (1.0f / YB_MUL); v[j].w += hi.y * (1.0f / YB_MUL); } }
            float s = 0.f; u32x2* xo = (u32x2*)(X2 + (size_t)tok * D) + c.lane;
#pragma unroll
            for (int j = 0; j < 8; ++j) { xo[64 * j] = (u32x2){pk2(v[j].x, v[j].y), pk2(v[j].z, v[j].w)}; s += (v[j].x * v[j].x + v[j].y * v[j].y) + (v[j].z * v[j].z + v[j].w * v[j].w); }
            const float rstd = 1.0f / sqrtf(wave_sum(s) * (1.0f / D) + RMS_EPS);
            unsigned* o4 = (unsigned*)((unsigned char*)HP + (size_t)tok * D) + c.lane; const float rs = rstd * FP8_MUL_X;
#pragma unroll
            for (int j = 0; j < 8; ++j) { const f32x4 gg = ((const f32x4*)g)[c.lane + 64 * j];
                o4[64 * j] = pk4_fp8(v[j].x * rs * gg.x, v[j].y * rs * gg.y, v[j].z * rs * gg.z, v[j].w * rs * gg.w); }
        }
    }
}

__device__ __forceinline__ void ph_gemm_ple(const Prm& p, const Ctx& c) {
    unsigned char* ws = p.ws;
    ProbPLE P{(const bf16_t*)(ws + WS_HP), (const bf16_t*)(ws + WS_WPG), (const bf16_t*)(ws + WS_X2), (const bf16_t*)(ws + WS_PP), (bf16_t*)(ws + WS_X3), D / 2};
    pg8::Order S; S.init(M / 256, D / 256, c.nvb, c.vb, nullptr); pg8::gemm_phase<ProbPLE, true, true>(c.lds, P, S);
}

__device__ __forceinline__ void ph_final(const Prm& p, const Ctx& c) {
    const float* g = p.in[27];
    const int gw = c.vb * NWAVES + c.wave, NGW = c.nvb * NWAVES;
    for (int tok0 = gw; tok0 < M; tok0 += 2 * NGW) {
        const bool two = tok0 + NGW < M; int tk[2]; tk[0] = tok0; tk[1] = two ? tok0 + NGW : tok0;
        u32x2 xw[2][8];
#pragma unroll
        for (int t = 0; t < 2; ++t) { const u32x2* xi = (const u32x2*)((const bf16_t*)(p.ws + WS_X3) + (size_t)tk[t] * D) + c.lane;
#pragma unroll
            for (int j = 0; j < 8; ++j) xw[t][j] = xi[64 * j]; }
#pragma unroll
        for (int t = 0; t < 2; ++t) { if (t == 1 && !two) break;
            f32x4* xr = (f32x4*)(p.out + (size_t)tk[t] * D) + c.lane; f32x4 v[8]; float s = 0.f;
#pragma unroll
            for (int j = 0; j < 8; ++j) { v[j] = (f32x4){bf_lo(xw[t][j].x), bf_hi(xw[t][j].x), bf_lo(xw[t][j].y), bf_hi(xw[t][j].y)}; s += (v[j].x * v[j].x + v[j].y * v[j].y) + (v[j].z * v[j].z + v[j].w * v[j].w); }
            const float rstd = 1.0f / sqrtf(wave_sum(s) * (1.0f / D) + RMS_EPS);
#pragma unroll
            for (int j = 0; j < 8; ++j) { const f32x4 gg = ((const f32x4*)g)[c.lane + 64 * j]; xr[64 * j] = (f32x4){v[j].x * rstd * gg.x, v[j].y * rstd * gg.y, v[j].z * rstd * gg.z, v[j].w * rstd * gg.w}; }
        }
    }
}

constexpr int NPHASE = 15;
template <int PH> __device__ __forceinline__ void run_phase(const Prm& p, const Ctx& c) {
    if constexpr (PH == 0) ph_prologue(p, c);
    else if constexpr (PH == 1) ph_gemm_in(p, c);
    else if constexpr (PH == 2) ph_lora_in(p, c);
    else if constexpr (PH == 3) ph_gemm_lora(p, c);
    else if constexpr (PH == 4) ph_chunk_pre(p, c);
    else if constexpr (PH == 5) ph_chunk_state(p, c);
    else if constexpr (PH == 6) ph_chunk_out(p, c);
    else if constexpr (PH == 7) ph_gemm_out(p, c);
    else if constexpr (PH == 8) ph_route(p, c);
    else if constexpr (PH == 9) ph_place(p, c);
    else if constexpr (PH == 10) ph_gemm_gu(p, c);
    else if constexpr (PH == 11) ph_gemm_dn(p, c);
    else if constexpr (PH == 12) ph_combine(p, c);
    else if constexpr (PH == 13) ph_gemm_ple(p, c);
    else ph_final(p, c);
}
__device__ __forceinline__ Ctx make_ctx(unsigned char* lds) {
    Ctx c; c.lds = (LAS unsigned char*)lds; c.tid = threadIdx.x; asm volatile("" : "+v"(c.tid)); c.lane = c.tid & 63; c.wave = __builtin_amdgcn_readfirstlane(c.tid >> 6); c.vb = blockIdx.x; c.nvb = gridDim.x; return c;
}

template <int PH> __global__ void __launch_bounds__(NTHR, 2) k_phase(Prm p) {
    extern __shared__ __attribute__((aligned(16))) unsigned char lds[];
    const Ctx c = make_ctx(lds);
    run_phase<PH>(p, c);
}

__global__ void __launch_bounds__(NTHR, 2) k_all(Prm p) {
    extern __shared__ __attribute__((aligned(16))) unsigned char lds[];
    const Ctx c = make_ctx(lds);
    if (c.tid < 4) ((LAS unsigned*)(c.lds + LDS_BARW))[c.tid] = 0u;
    __syncthreads();
    XcdBarrier bar = xcd_barrier_post((unsigned*)(p.ws + WS_CTL) + CW_BAR, (volatile LAS unsigned*)(c.lds + LDS_BARW));
#define RUN_PH(k) do { const Ctx c = make_ctx(lds); run_phase<k>(p, c); if ((REP_MASK >> (k)) & 1) { xcd_barrier(bar); \
        run_phase<k>(p, c); } } while (0)
    RUN_PH(0); xcd_barrier(bar);
    RUN_PH(1); xcd_barrier(bar);
    RUN_PH(2); xcd_barrier(bar);
    RUN_PH(3); xcd_barrier(bar);
    RUN_PH(4); xcd_barrier(bar);
    RUN_PH(5); xcd_barrier(bar);
    RUN_PH(6); xcd_barrier(bar);
    RUN_PH(7); xcd_barrier(bar);
    RUN_PH(8); xcd_barrier(bar);
    RUN_PH(9); xcd_barrier(bar);
    RUN_PH(10); xcd_barrier(bar);
    RUN_PH(11); xcd_barrier(bar);
    RUN_PH(12); xcd_barrier(bar);
    RUN_PH(13); xcd_barrier(bar);
    RUN_PH(14);
}

template <int PH> static void launch_phase(const Prm& prm, int grid, hipStream_t stream) {
    static bool attr = false;
    if (!attr) { (void)hipFuncSetAttribute((const void*)k_phase<PH>, hipFuncAttributeMaxDynamicSharedMemorySize, LDS_BYTES); attr = true; }
    hipLaunchKernelGGL(k_phase<PH>, dim3(grid), dim3(NTHR), LDS_BYTES, stream, prm);
}

extern "C" void kernel_launch(void* const* d_in, const int* in_sizes, int n_in, void* d_out, int out_size, void* d_ws, size_t ws_size, hipStream_t stream) {
    static int grid = 0;
    if (grid == 0) {
        if (n_in != 28 || out_size != M * D || ws_size < WS_END) { fprintf(stderr, "kernel_launch: unexpected shapes (n_in %d out %d ws %zu need %zu)\n", n_in, out_size, ws_size, (size_t)WS_END); grid = -1; return; }
        int dev = 0, cus = 0;
        if (hipGetDevice(&dev) != hipSuccess || hipDeviceGetAttribute(&cus, hipDeviceAttributeMultiprocessorCount, dev) != hipSuccess || cus < 1) { grid = -1; return; }
        (void)hipFuncSetAttribute((const void*)k_all, hipFuncAttributeMaxDynamicSharedMemorySize, LDS_BYTES);
        int per_cu = 0; (void)hipOccupancyMaxActiveBlocksPerMultiprocessor(&per_cu, (const void*)k_all, NTHR, LDS_BYTES); (void)hipGetLastError();
        grid = cus;
    }
    if (grid < 0) return;
    (void)hipMemsetAsync((char*)d_ws + WS_CTL, 0, CTL_BYTES, stream);
    Prm prm{};
    for (int i = 0; i < 28; ++i) prm.in[i] = (const float*)d_in[i];
    prm.out = (float*)d_out; prm.ws = (unsigned char*)d_ws;
#if N_LAUNCH_MODE == 1
    hipLaunchKernelGGL(k_all, dim3(grid), dim3(NTHR), LDS_BYTES, stream, prm);
#else
    launch_phase<0>(prm, grid, stream); launch_phase<1>(prm, grid, stream); launch_phase<2>(prm, grid, stream); launch_phase<3>(prm, grid, stream);
    launch_phase<4>(prm, grid, stream); launch_phase<5>(prm, grid, stream); launch_phase<6>(prm, grid, stream); launch_phase<7>(prm, grid, stream);
    launch_phase<8>(prm, grid, stream); launch_phase<9>(prm, grid, stream); launch_phase<10>(prm, grid, stream); launch_phase<11>(prm, grid, stream);
    launch_phase<12>(prm, grid, stream); launch_phase<13>(prm, grid, stream); launch_phase<14>(prm, grid, stream);
#endif
}
```
